# Optimizing an MI355X kernel written in HIP

```python
import jax, jax.numpy as jnp
from jax import lax
import numpy as np

D_MODEL = 1024
BATCH = 2
SEQ = 8192
DEPTH = 1

EPS = 1e-6
D_FF = 2816
MLA_HEADS = 8
MLA_Q_RANK = 384
MLA_KV_RANK = 256
MLA_NOPE = 64
MLA_ROPE = 32
MLA_V = 64
MLA_THETA = 10000.0
MLA_WIDTH = MLA_HEADS * MLA_V
DIL_HEADS = 8
DIL_HEAD_DIM = 64
DIL_PATTERNS = ((128, 1), (512, 4), (2048, 16))
DIL_WIDTH = DIL_HEADS * DIL_HEAD_DIM
ROPE_THETA = 500000.0
ROPE_DIM = DIL_HEAD_DIM // 4
N_BRANCH = 2
Q_BLOCK = 128
NEG = -1e30
IN_SPLITS = (MLA_Q_RANK, MLA_KV_RANK, MLA_ROPE, DIL_WIDTH, DIL_WIDTH, DIL_WIDTH, N_BRANCH * D_MODEL)
IN_DIM = int(sum(IN_SPLITS))

kernel_name = 'hybrid_mla_dilated_macaron_block'


def rms_norm(x, g):
    xf = x.astype(jnp.float32)
    y = xf * lax.rsqrt(jnp.mean(xf * xf, axis=-1, keepdims=True) + EPS)
    return (y * g.astype(jnp.float32)).astype(x.dtype)


def rope(x, positions, theta, rot_dim):
    half = rot_dim // 2
    inv = 1.0 / (jnp.float32(theta) ** (jnp.arange(half, dtype=jnp.float32) / half))
    ang = positions.astype(jnp.float32)[:, :, None] * inv
    cos = jnp.cos(ang)[:, :, None, :]
    sin = jnp.sin(ang)[:, :, None, :]
    xr = x[..., :rot_dim].astype(jnp.float32)
    x1, x2 = xr[..., :half], xr[..., half:]
    rot = jnp.concatenate([x1 * cos - x2 * sin, x2 * cos + x1 * sin], axis=-1).astype(x.dtype)
    return jnp.concatenate([rot, x[..., rot_dim:]], axis=-1)


def swiglu(x, w_gate, w_up, w_down):
    return (jax.nn.silu(x @ w_gate) * (x @ w_up)) @ w_down


def dense_attention(q, k, v):
    B, S, H, Dk = q.shape
    scale = Dk ** -0.5
    nqb = S // Q_BLOCK
    qb = q.reshape(B, nqb, Q_BLOCK, H, Dk).transpose(1, 0, 2, 3, 4)

    def block(qi):
        s = jnp.einsum('bqhd,bkhd->bhqk', qi, k, preferred_element_type=jnp.float32) * scale
        p = jax.nn.softmax(s, axis=-1)
        return jnp.einsum('bhqk,bkhd->bqhd', p, v.astype(jnp.float32)).astype(v.dtype)

    o = lax.map(block, qb)
    return o.transpose(1, 0, 2, 3, 4).reshape(B, S, H, v.shape[-1])


def dilated_pattern(q, k, v, window, dilation):
    B, S, H, D = q.shape
    half = window // (2 * dilation)
    blk = half
    L = -(-S // dilation)
    Sp = L * dilation
    nb = -(-L // blk)
    Lp = nb * blk

    def split(t):
        t = jnp.pad(t, ((0, 0), (0, Sp - S), (0, 0), (0, 0)))
        return t.reshape(B, L, dilation, H, t.shape[-1]).transpose(0, 2, 3, 1, 4)

    def pad_l(t, lo, hi):
        return jnp.pad(t, ((0, 0), (0, 0), (0, 0), (lo, hi), (0, 0)))

    qs = pad_l(split(q), 0, Lp - L).reshape(B, dilation, H, nb, blk, D)

    def windows(t):
        dt = t.shape[-1]
        t = pad_l(split(t), blk, Lp - L + blk).reshape(B, dilation, H, nb + 2, blk, dt)
        return jnp.concatenate([t[:, :, :, :-2], t[:, :, :, 1:-1], t[:, :, :, 2:]], axis=-2)

    kw = windows(k)
    vw = windows(v)
    s = jnp.einsum('brhnqd,brhnkd->brhnqk', qs, kw, preferred_element_type=jnp.float32) * (D ** -0.5)
    a = jnp.arange(blk)[:, None]
    c = jnp.arange(3 * blk)[None, :]
    band = jnp.abs(c - blk - a) <= half
    jk = jnp.arange(nb)[:, None] * blk - blk + jnp.arange(3 * blk)[None, :]
    pos_k = jk[None] * dilation + jnp.arange(dilation)[:, None, None]
    valid = (jk[None] >= 0) & (pos_k < S)
    mask = band[None, None] & valid[:, :, None, :]
    s = jnp.where(mask[None, :, None], s, NEG)
    m = jnp.max(s, axis=-1, keepdims=True)
    p = jnp.exp(s - m)
    den = jnp.sum(p, axis=-1, keepdims=True)
    num = jnp.einsum('brhnqk,brhnkd->brhnqd', p, vw.astype(jnp.float32))

    def merge(t):
        x_ = t.shape[-1]
        t = t.reshape(B, dilation, H, Lp, x_)[:, :, :, :L]
        return t.transpose(0, 3, 1, 2, 4).reshape(B, Sp, H, x_)[:, :S]

    return merge(m), merge(den), merge(num)


def dilated_mixture(q, k, v):
    parts = [dilated_pattern(q, k, v, w, d) for (w, d) in DIL_PATTERNS]
    m_all = jnp.max(jnp.concatenate([pm for pm, _, _ in parts], axis=-1), axis=-1, keepdims=True)
    num = None
    den = None
    for pm, ps, pn in parts:
        wgt = jnp.exp(pm - m_all)
        num = wgt * pn if num is None else num + wgt * pn
        den = wgt * ps if den is None else den + wgt * ps
    return (num / den).astype(q.dtype)


def hybrid_mixer(u, positions, w_in, b_gate, q_norm_g, w_uq, kv_norm_g, w_uk, w_uv,
                 w_branch_a, w_branch_b, w_out):
    B, S, _ = u.shape
    proj = u @ w_in
    cq, ckv, kr, dq, dk, dv, g = jnp.split(proj, np.cumsum(IN_SPLITS)[:-1].tolist(), axis=-1)

    q = (rms_norm(cq, q_norm_g) @ w_uq).reshape(B, S, MLA_HEADS, MLA_NOPE + MLA_ROPE)
    q = jnp.concatenate([q[..., :MLA_NOPE], rope(q[..., MLA_NOPE:], positions, MLA_THETA, MLA_ROPE)], axis=-1)
    k_rope = rope(kr[:, :, None, :], positions, MLA_THETA, MLA_ROPE)
    c_kv = rms_norm(ckv, kv_norm_g)
    k_nope = (c_kv @ w_uk).reshape(B, S, MLA_HEADS, MLA_NOPE)
    v_a = (c_kv @ w_uv).reshape(B, S, MLA_HEADS, MLA_V)
    k_a = jnp.concatenate([k_nope, jnp.broadcast_to(k_rope, (B, S, MLA_HEADS, MLA_ROPE))], axis=-1)
    o_a = dense_attention(q, k_a, v_a).reshape(B, S, MLA_WIDTH)

    qd = rope(dq.reshape(B, S, DIL_HEADS, DIL_HEAD_DIM), positions, ROPE_THETA, ROPE_DIM)
    kd = rope(dk.reshape(B, S, DIL_HEADS, DIL_HEAD_DIM), positions, ROPE_THETA, ROPE_DIM)
    vd = dv.reshape(B, S, DIL_HEADS, DIL_HEAD_DIM)
    o_b = dilated_mixture(qd, kd, vd).reshape(B, S, DIL_WIDTH)

    gates = jax.nn.sigmoid((g + b_gate).reshape(B, S, N_BRANCH, D_MODEL))
    merged = gates[:, :, 0] * (o_a @ w_branch_a) + gates[:, :, 1] * (o_b @ w_branch_b)
    return merged @ w_out


def setup_inputs(seed: int = 0) -> dict:
    key = jax.random.key(seed)
    ks = iter(jax.random.split(key, 32))

    def w(shape, fan_in):
        return jax.random.normal(next(ks), (DEPTH,) + shape, jnp.float32) * (fan_in ** -0.5)

    def gain(n):
        return 1.0 + 0.05 * jax.random.normal(next(ks), (DEPTH, n), jnp.float32)

    x = jax.random.normal(next(ks), (BATCH, SEQ, D_MODEL), jnp.float32)
    offset = jax.random.randint(next(ks), (BATCH, 1), 0, 4096, dtype=jnp.int32)
    positions = (offset + jnp.arange(SEQ, dtype=jnp.int32)[None, :]).astype(jnp.int32)
    return {
        'x': x,
        'positions': positions,
        'ffn1_pre_g': gain(D_MODEL),
        'ffn1_post_g': gain(D_MODEL),
        'ffn1_w_gate': w((D_MODEL, D_FF), D_MODEL),
        'ffn1_w_up': w((D_MODEL, D_FF), D_MODEL),
        'ffn1_w_down': w((D_FF, D_MODEL), D_FF),
        'mix_pre_g': gain(D_MODEL),
        'w_in': w((D_MODEL, IN_DIM), D_MODEL),
        'b_gate': 0.1 * jax.random.normal(next(ks), (DEPTH, N_BRANCH * D_MODEL), jnp.float32),
        'q_norm_g': gain(MLA_Q_RANK),
        'w_uq': w((MLA_Q_RANK, MLA_HEADS * (MLA_NOPE + MLA_ROPE)), MLA_Q_RANK),
        'kv_norm_g': gain(MLA_KV_RANK),
        'w_uk': w((MLA_KV_RANK, MLA_HEADS * MLA_NOPE), MLA_KV_RANK),
        'w_uv': w((MLA_KV_RANK, MLA_HEADS * MLA_V), MLA_KV_RANK),
        'w_branch_a': w((MLA_WIDTH, D_MODEL), MLA_WIDTH),
        'w_branch_b': w((DIL_WIDTH, D_MODEL), DIL_WIDTH),
        'w_out': w((D_MODEL, D_MODEL), D_MODEL),
        'mix_post_g': gain(D_MODEL),
        'ffn2_pre_g': gain(D_MODEL),
        'ffn2_post_g': gain(D_MODEL),
        'ffn2_w_gate': w((D_MODEL, D_FF), D_MODEL),
        'ffn2_w_up': w((D_MODEL, D_FF), D_MODEL),
        'ffn2_w_down': w((D_FF, D_MODEL), D_FF),
    }


def reference(x, positions, ffn1_pre_g, ffn1_post_g, ffn1_w_gate, ffn1_w_up, ffn1_w_down,
              mix_pre_g, w_in, b_gate, q_norm_g, w_uq, kv_norm_g, w_uk, w_uv,
              w_branch_a, w_branch_b, w_out, mix_post_g,
              ffn2_pre_g, ffn2_post_g, ffn2_w_gate, ffn2_w_up, ffn2_w_down):
    h = x
    for l in range(DEPTH):
        f1 = swiglu(rms_norm(h, ffn1_pre_g[l]), ffn1_w_gate[l], ffn1_w_up[l], ffn1_w_down[l])
        h = h + 0.5 * rms_norm(f1, ffn1_post_g[l])
        mix = hybrid_mixer(rms_norm(h, mix_pre_g[l]), positions, w_in[l], b_gate[l],
                           q_norm_g[l], w_uq[l], kv_norm_g[l], w_uk[l], w_uv[l],
                           w_branch_a[l], w_branch_b[l], w_out[l])
        h = h + rms_norm(mix, mix_post_g[l])
        f2 = swiglu(rms_norm(h, ffn2_pre_g[l]), ffn2_w_gate[l], ffn2_w_up[l], ffn2_w_down[l])
        h = h + 0.5 * rms_norm(f2, ffn2_post_g[l])
    return h
```

```cpp
#include <hip/hip_runtime.h>
#include <cstdio>
#include <cstdint>
#include <cmath>
namespace pg8 {
#define PG8_LAS __attribute__((address_space(3)))
typedef unsigned short bf16_t;
typedef short bf16x8 __attribute__((ext_vector_type(8)));
typedef float f32x4 __attribute__((ext_vector_type(4)));
typedef unsigned u32x4 __attribute__((ext_vector_type(4)));
constexpr int BM = 256, BK = 64, HALF = 128, HTB = HALF * BK * 2  , STAGE_BYTES = 8 * HTB, NXCD = 8, WGM = 8;

__host__ __device__ __forceinline__ int lds_byte(int r, int c) { const int st = (r >> 4) * 2 + (c >> 5), rr = r & 15, cc = c & 31, ob = rr * 64 + cc * 2; return st * 1024 + (ob ^ (((ob >> 9) & 1) << 5)); }
__host__ __device__ __forceinline__ void stage_rc(int b, int& R, int& C) { const int st = b / 1024, sb = b % 1024, swz = sb ^ (((sb >> 9) & 1) << 5); R = (st >> 1) * 16 + swz / 64; C = (st & 1) * 32 + (swz % 64) / 2; }
__host__ __device__ __forceinline__ int perm32(int rho) { const int n = rho >> 4, i = rho & 15; return 8 * (i >> 2) + 4 * n + (i & 3); }

struct Unit { int pm, pn; };
struct Gemm { const bf16_t* A; const bf16_t* Bt; int M, N, K, pad; };

struct StaticOrder {
    int nM, nN, nwg, G, c;
    __host__ __device__ void init(int M, int N, int G_, int c_) { nM = M / BM; nN = N / BM; nwg = nM * nN; G = G_; c = c_; }
    __host__ __device__ bool next(int i, Unit& u) const {
        const long L = (long)i * G + c; if (L >= nwg) return false;
        int wgid = (int)L; { const int q = nwg / NXCD, r = nwg % NXCD, xcd = wgid % NXCD, off = wgid / NXCD; wgid = (xcd < r ? xcd * (q + 1) : r * (q + 1) + (xcd - r) * q) + off; }
        const int nig = WGM * nN, gid = wgid / nig, fm = gid * WGM, gsz = (nM - fm) < WGM ? (nM - fm) : WGM;
        u.pm = fm + ((wgid % nig) % gsz); u.pn = (wgid % nig) / gsz; return true;
    }
    __device__ __forceinline__ void a_ready(const Unit&) const {}
    __device__ __forceinline__ void done(const Unit&) const {}
};

__device__ __forceinline__ unsigned cvt_pk_bf16(float lo, float hi) { unsigned r; asm volatile("v_cvt_pk_bf16_f32 %0, %1, %2" : "=v"(r) : "v"(lo), "v"(hi)); return r; }
__device__ __forceinline__ float bf_lo(unsigned w) { return __uint_as_float(w << 16); }
__device__ __forceinline__ float bf_hi(unsigned w) { return __uint_as_float(w & 0xffff0000u); }
__device__ __forceinline__ float sigm(float x) { return __builtin_amdgcn_rcpf(1.0f + __builtin_amdgcn_exp2f(-1.4426950408889634f * x)); }
__device__ __forceinline__ u32x4 pack8(const float (&v)[8]) { u32x4 w; w.x = cvt_pk_bf16(v[0], v[1]); w.y = cvt_pk_bf16(v[2], v[3]); w.z = cvt_pk_bf16(v[4], v[5]); w.w = cvt_pk_bf16(v[6], v[7]); return w; }

struct EpiF32 {
    static constexpr bool PERM = false, AFTER_DRAIN = false;
    float* C; int ldc; int pad;
    __device__ __forceinline__ void operator()(const f32x4 (&acc)[2][2][4][2], const Unit& u, int wr, int wc, int fr, int fq) const {
        const int row0 = u.pm * BM + wr * 64 + fr, col0 = u.pn * BM + wc * 32 + 4 * fq;
#pragma unroll
        for (int ai = 0; ai < 2; ++ai)
#pragma unroll
            for (int m = 0; m < 4; ++m) { float* rowp = C + (size_t)(row0 + ai * HALF + m * 16) * ldc + col0;
#pragma unroll
                for (int bj = 0; bj < 2; ++bj)
#pragma unroll
                    for (int n = 0; n < 2; ++n) *(f32x4*)(rowp + bj * HALF + n * 16) = acc[ai][bj][m][n]; }
    }
};

struct EpiSwiGLU {
    static constexpr bool PERM = true, AFTER_DRAIN = false;
    bf16_t* O; int ldc; int pad;
    __device__ __forceinline__ void operator()(const f32x4 (&acc)[2][2][4][2], const Unit& u, int wr, int wc, int fr, int fq) const {
        const int row0 = u.pm * BM + wr * 64 + fr, col0 = u.pn * HALF + wc * 32 + 8 * fq;
#pragma unroll
        for (int ai = 0; ai < 2; ++ai)
#pragma unroll
            for (int m = 0; m < 4; ++m) { bf16_t* rowp = O + (size_t)(row0 + ai * HALF + m * 16) * ldc + col0;
                float o[8];
#pragma unroll
                for (int n = 0; n < 2; ++n)
#pragma unroll
                    for (int i = 0; i < 4; ++i) { const float g = acc[ai][0][m][n][i], up = acc[ai][1][m][n][i]; o[4 * n + i] = g * sigm(g) * up; }
                *(u32x4*)rowp = pack8(o); }
    }
};

struct EpiInProj {
    static constexpr bool PERM = true, AFTER_DRAIN = false;
    bf16_t *CQ, *CKV, *KR, *DQ, *DK, *DV, *GT; float* SSQ; const float* bgate; const float* ropeA; const float* ropeB; float qscale; int pad;
    __device__ __forceinline__ void operator()(const f32x4 (&acc)[2][2][4][2], const Unit& u, int wr, int wc, int fr, int fq) const {
        const int row0 = u.pm * BM + wr * 64 + fr;
#pragma unroll
        for (int bj = 0; bj < 2; ++bj) {
            const int G = u.pn * 8 + bj * 4 + wc;
            if (G >= 21 && G < 24) continue;
            f32x4 b0 = (f32x4){0.f, 0.f, 0.f, 0.f}, b1 = b0;
            if (G >= 72) { const float* bp = bgate + (G - 72) * 32 + 8 * fq; b0 = *(const f32x4*)bp; b1 = *(const f32x4*)(bp + 4); }
#pragma unroll
            for (int ai = 0; ai < 2; ++ai)
#pragma unroll
                for (int m = 0; m < 4; ++m) {
                    const int row = row0 + ai * HALF + m * 16;
                    float v[8];
#pragma unroll
                    for (int i = 0; i < 4; ++i) { v[i] = acc[ai][bj][m][0][i]; v[4 + i] = acc[ai][bj][m][1][i]; }
                    if (G < 20) {
                        float ss = 0.f;
#pragma unroll
                        for (int i = 0; i < 8; ++i) ss += v[i] * v[i];
                        ss += __shfl_xor(ss, 16); ss += __shfl_xor(ss, 32);
                        if (fq == 0) SSQ[(size_t)row * 20 + G] = ss;
                        bf16_t* dst = (G < 12) ? CQ + (size_t)row * 384 + G * 32 + 8 * fq : CKV + (size_t)row * 256 + (G - 12) * 32 + 8 * fq;
                        *(u32x4*)dst = pack8(v);
                    } else if (G == 20) {
                        const float* rp = ropeA + (size_t)row * 32 + 8 * (fq & 1);
                        const f32x4 c0 = *(const f32x4*)rp, c1 = *(const f32x4*)(rp + 4), s0 = *(const f32x4*)(rp + 16), s1 = *(const f32x4*)(rp + 20);
                        float o[8];
#pragma unroll
                        for (int i = 0; i < 8; ++i) { const float p = __shfl_xor(v[i], 32); const float c = i < 4 ? c0[i] : c1[i - 4], s = i < 4 ? s0[i] : s1[i - 4];
                            o[i] = (fq < 2) ? v[i] * c - p * s : v[i] * c + p * s; }
                        *(u32x4*)(KR + (size_t)row * 32 + 8 * fq) = pack8(o);
                    } else if (G < 56) {
                        const bool isq = G < 40; const int g2 = isq ? G - 24 : G - 40;
                        float o[8];
                        if ((g2 & 1) == 0) {
                            const float* rp = ropeB + (size_t)row * 16;
                            const f32x4 c0 = *(const f32x4*)rp, c1 = *(const f32x4*)(rp + 4), s0 = *(const f32x4*)(rp + 8), s1 = *(const f32x4*)(rp + 12);
#pragma unroll
                            for (int i = 0; i < 8; ++i) { const float p = __shfl_xor(v[i], 16); const float c = i < 4 ? c0[i] : c1[i - 4], s = i < 4 ? s0[i] : s1[i - 4];
                                o[i] = (fq == 0) ? v[i] * c - p * s : (fq == 1) ? v[i] * c + p * s : v[i]; }
                        } else {
#pragma unroll
                            for (int i = 0; i < 8; ++i) o[i] = v[i];
                        }
                        if (isq) {
#pragma unroll
                            for (int i = 0; i < 8; ++i) o[i] *= qscale;
                        }
                        bf16_t* dst = (isq ? DQ : DK) + (size_t)row * 512 + g2 * 32 + 8 * fq;
                        *(u32x4*)dst = pack8(o);
                    } else if (G < 72) {
                        *(u32x4*)(DV + (size_t)row * 512 + (G - 56) * 32 + 8 * fq) = pack8(v);
                    } else {
                        float o[8];
#pragma unroll
                        for (int i = 0; i < 4; ++i) { o[i] = sigm(v[i] + b0[i]); o[4 + i] = sigm(v[4 + i] + b1[i]); }
                        *(u32x4*)(GT + (size_t)row * 2048 + (G - 72) * 32 + 8 * fq) = pack8(o);
                    }
                }
        }
    }
};

struct EpiQUp {
    static constexpr bool PERM = true, AFTER_DRAIN = false;
    bf16_t* Q; const float* SSQ; const float* ropeA; float qscale; float eps;
    __device__ __forceinline__ void operator()(const f32x4 (&acc)[2][2][4][2], const Unit& u, int wr, int wc, int fr, int fq) const {
        const int row0 = u.pm * BM + wr * 64 + fr;
#pragma unroll
        for (int ai = 0; ai < 2; ++ai)
#pragma unroll
            for (int m = 0; m < 4; ++m) {
                const int row = row0 + ai * HALF + m * 16;
                const float* sp = SSQ + (size_t)row * 20;
                const f32x4 a = *(const f32x4*)sp, b = *(const f32x4*)(sp + 4), c = *(const f32x4*)(sp + 8);
                const float ss = ((a[0] + a[1]) + (a[2] + a[3])) + ((b[0] + b[1]) + (b[2] + b[3])) + ((c[0] + c[1]) + (c[2] + c[3]));
                const float rs = __builtin_amdgcn_rsqf(ss * (1.0f / 384.0f) + eps) * qscale;
#pragma unroll
                for (int bj = 0; bj < 2; ++bj) {
                    const int G = u.pn * 8 + bj * 4 + wc;
                    float v[8];
#pragma unroll
                    for (int i = 0; i < 4; ++i) { v[i] = acc[ai][bj][m][0][i] * rs; v[4 + i] = acc[ai][bj][m][1][i] * rs; }
                    if (G % 3 == 2) {
                        const float* rp = ropeA + (size_t)row * 32 + 8 * (fq & 1);
                        const f32x4 c0 = *(const f32x4*)rp, c1 = *(const f32x4*)(rp + 4), s0 = *(const f32x4*)(rp + 16), s1 = *(const f32x4*)(rp + 20);
#pragma unroll
                        for (int i = 0; i < 8; ++i) { const float p = __shfl_xor(v[i], 32); const float cc = i < 4 ? c0[i] : c1[i - 4], s = i < 4 ? s0[i] : s1[i - 4];
                            v[i] = (fq < 2) ? v[i] * cc - p * s : v[i] * cc + p * s; }
                    }
                    *(u32x4*)(Q + (size_t)row * 768 + G * 32 + 8 * fq) = pack8(v);
                }
            }
    }
};

struct EpiKVUp {
    static constexpr bool PERM = true, AFTER_DRAIN = false;
    bf16_t *KN, *VA; const float* SSQ; float eps; int pad;
    __device__ __forceinline__ void operator()(const f32x4 (&acc)[2][2][4][2], const Unit& u, int wr, int wc, int fr, int fq) const {
        const int row0 = u.pm * BM + wr * 64 + fr;
#pragma unroll
        for (int ai = 0; ai < 2; ++ai)
#pragma unroll
            for (int m = 0; m < 4; ++m) {
                const int row = row0 + ai * HALF + m * 16;
                const float* sp = SSQ + (size_t)row * 20 + 12;
                const f32x4 a = *(const f32x4*)sp, b = *(const f32x4*)(sp + 4);
                const float ss = ((a[0] + a[1]) + (a[2] + a[3])) + ((b[0] + b[1]) + (b[2] + b[3]));
                const float rs = __builtin_amdgcn_rsqf(ss * (1.0f / 256.0f) + eps);
#pragma unroll
                for (int bj = 0; bj < 2; ++bj) {
                    const int c = u.pn * BM + bj * HALF + wc * 32 + 8 * fq;
                    float v[8];
#pragma unroll
                    for (int i = 0; i < 4; ++i) { v[i] = acc[ai][bj][m][0][i] * rs; v[4 + i] = acc[ai][bj][m][1][i] * rs; }
                    bf16_t* dst = (c < 512) ? KN + (size_t)row * 512 + c : VA + (size_t)row * 512 + (c - 512);
                    *(u32x4*)dst = pack8(v);
                }
            }
    }
};

template <bool FIRST> struct EpiGate {
    static constexpr bool PERM = true, AFTER_DRAIN = false;
    bf16_t* MG; const bf16_t* GT;
    __device__ __forceinline__ void operator()(const f32x4 (&acc)[2][2][4][2], const Unit& u, int wr, int wc, int fr, int fq) const {
        const int row0 = u.pm * BM + wr * 64 + fr, col0 = u.pn * BM + wc * 32 + 8 * fq;
#pragma unroll
        for (int ai = 0; ai < 2; ++ai)
#pragma unroll
            for (int m = 0; m < 4; ++m) {
                const int row = row0 + ai * HALF + m * 16;
#pragma unroll
                for (int bj = 0; bj < 2; ++bj) {
                    const int c = col0 + bj * HALF;
                    const u32x4 gw = *(const u32x4*)(GT + (size_t)row * 2048 + (FIRST ? 0 : 1024) + c);
                    float v[8];
#pragma unroll
                    for (int i = 0; i < 4; ++i) { v[i] = acc[ai][bj][m][0][i]; v[4 + i] = acc[ai][bj][m][1][i]; }
                    v[0] *= bf_lo(gw.x); v[1] *= bf_hi(gw.x); v[2] *= bf_lo(gw.y); v[3] *= bf_hi(gw.y); v[4] *= bf_lo(gw.z); v[5] *= bf_hi(gw.z); v[6] *= bf_lo(gw.w); v[7] *= bf_hi(gw.w);
                    bf16_t* dst = MG + (size_t)row * 1024 + c;
                    if (!FIRST) { const u32x4 pw = *(const u32x4*)dst;
                        v[0] += bf_lo(pw.x); v[1] += bf_hi(pw.x); v[2] += bf_lo(pw.y); v[3] += bf_hi(pw.y); v[4] += bf_lo(pw.z); v[5] += bf_hi(pw.z); v[6] += bf_lo(pw.w); v[7] += bf_hi(pw.w); }
                    *(u32x4*)dst = pack8(v);
                }
            }
    }
};
template <class Epi, class Sched, bool ALIGN_EPI = false, bool SP2 = false>
__device__ __forceinline__ void gemm_phase(PG8_LAS unsigned char* lds, const Gemm g, const Sched& S, const Epi& E) {
    const int tid = threadIdx.x, wid = __builtin_amdgcn_readfirstlane(tid >> 6), lane = tid & 63, wr = wid >> 2, wc = wid & 3, fr = lane & 15, fq = lane >> 4;
    const int K = g.K, nt = K / BK;
    unsigned voffA[2], voffB[2];
#pragma unroll
    for (int i = 0; i < 2; ++i) { int R, C; stage_rc(tid * 16 + i * 8192, R, C); const int Rb = Epi::PERM ? ((R & ~31) + perm32(R & 31)) : R;
        voffA[i] = (unsigned)(R * K + C) * 2u; voffB[i] = (unsigned)(Rb * K + C) * 2u; }
    const size_t kstep = (size_t)(BK * 2);
    const size_t hstep = (size_t)HALF * K * 2;
    const size_t tstep = 2 * hstep;
    const unsigned ldsw = (unsigned)wid * 1024u;
    const int aoff = lds_byte(wr * 64 + fr, fq * 8), boff = lds_byte(wc * 32 + fr, fq * 8);
#define PG8_SA(b, h) (((b) * 2 + (h)) * HTB)
#define PG8_SB(b, h) ((4 + (b) * 2 + (h)) * HTB)
#define PG8_STAGE(bufoff, gbase, voff) do { _Pragma("unroll") for (int _i = 0; _i < 2; ++_i) \
        __builtin_amdgcn_global_load_lds((const unsigned*)((const char*)(gbase) + (voff)[_i]), (PG8_LAS unsigned*)(lds + (bufoff) + ldsw + _i * 8192), 16, 0, 0); } while (0)
#define PG8_LDA(dst, b, h) do { _Pragma("unroll") for (int m = 0; m < 4; ++m) _Pragma("unroll") for (int k = 0; k < 2; ++k) dst[m][k] = *(const PG8_LAS bf16x8*)(lds + PG8_SA(b, h) + aoff + m * 2048 + k * 1024); } while (0)
#define PG8_LDB(dst, b, h) do { _Pragma("unroll") for (int n = 0; n < 2; ++n) _Pragma("unroll") for (int k = 0; k < 2; ++k) dst[n][k] = *(const PG8_LAS bf16x8*)(lds + PG8_SB(b, h) + boff + n * 2048 + k * 1024); } while (0)
#define PG8_MMA(ai, bj, At, Bt) do { __builtin_amdgcn_s_setprio(1); _Pragma("unroll") for (int m = 0; m < 4; ++m) _Pragma("unroll") for (int n = 0; n < 2; ++n) _Pragma("unroll") for (int k = 0; k < 2; ++k) \
        acc[ai][bj][m][n] = __builtin_amdgcn_mfma_f32_16x16x32_bf16(Bt[n][k], At[m][k], acc[ai][bj][m][n], 0, 0, 0); __builtin_amdgcn_s_setprio(0); } while (0)
#define PG8_WAIT_V(n) asm volatile("s_waitcnt vmcnt(" #n ")" ::: "memory")
#define PG8_WAIT_L(n) asm volatile("s_waitcnt lgkmcnt(" #n ")" ::: "memory")
#define PG8_BAR __builtin_amdgcn_s_barrier()
#define PG8_SCHED __builtin_amdgcn_sched_barrier(0)
    Unit cur, nxt; int ui = 0;
    if (!S.next(0, cur)) return;
    f32x4 acc[2][2][4][2];
#pragma unroll
    for (int a = 0; a < 2; ++a)
#pragma unroll
        for (int b = 0; b < 2; ++b)
#pragma unroll
            for (int m = 0; m < 4; ++m)
#pragma unroll
                for (int n = 0; n < 2; ++n) acc[a][b][m][n] = (f32x4){0.f, 0.f, 0.f, 0.f};
    bf16x8 At[4][2], B0[2][2], B1[2][2];
    const char* cA = (const char*)g.A + (size_t)cur.pm * tstep; const char* cB = (const char*)g.Bt + (size_t)cur.pn * tstep;
    S.a_ready(cur);
    if constexpr (SP2) {
        PG8_STAGE(PG8_SB(0, 0), cB, voffB); PG8_STAGE(PG8_SB(0, 1), cB + hstep, voffB); PG8_STAGE(PG8_SA(0, 0), cA, voffA); PG8_STAGE(PG8_SA(0, 1), cA + hstep, voffA);
        if (wr == 1) PG8_BAR;
        PG8_WAIT_V(2); PG8_BAR;
        PG8_STAGE(PG8_SB(1, 0), cB + kstep, voffB); PG8_STAGE(PG8_SA(1, 0), cA + kstep, voffA); PG8_STAGE(PG8_SB(1, 1), cB + hstep + kstep, voffB);
        PG8_WAIT_V(6); PG8_BAR;
    } else {
        PG8_STAGE(PG8_SB(0, 0), cB, voffB); PG8_STAGE(PG8_SA(0, 0), cA, voffA); PG8_STAGE(PG8_SB(0, 1), cB + hstep, voffB); PG8_STAGE(PG8_SA(0, 1), cA + hstep, voffA);
        if (wr == 1) PG8_BAR;
        PG8_WAIT_V(4); PG8_BAR;
        PG8_STAGE(PG8_SB(1, 0), cB + kstep, voffB); PG8_STAGE(PG8_SA(1, 0), cA + kstep, voffA); PG8_STAGE(PG8_SB(1, 1), cB + hstep + kstep, voffB);
        PG8_WAIT_V(6); PG8_BAR;
    }
    for (;;) {
        const bool has_next = S.next(ui + 1, nxt);
        const char* nA = has_next ? (const char*)g.A + (size_t)nxt.pm * tstep : cA; const char* nB = has_next ? (const char*)g.Bt + (size_t)nxt.pn * tstep : cB;
        for (int t = 0; t < nt; t += 2) {
            const bool last = (t == nt - 2);
            const char* a1 = cA + (size_t)(t + 1) * kstep;
            const char* a2 = last ? nA : cA + (size_t)(t + 2) * kstep; const char* b2 = last ? nB : cB + (size_t)(t + 2) * kstep;
            const char* a3 = a2 + kstep; const char* b3 = b2 + kstep;
            if (last && has_next) S.a_ready(nxt);
            if constexpr (SP2) {
            PG8_LDB(B0, 0, 0); PG8_LDB(B1, 0, 1); PG8_SCHED; PG8_LDA(At, 0, 0); PG8_STAGE(PG8_SA(1, 1), a1 + hstep, voffA);
            PG8_WAIT_V(8); PG8_WAIT_L(0); PG8_BAR; PG8_MMA(0, 0, At, B0); PG8_MMA(0, 1, At, B1); PG8_BAR; PG8_SCHED;
            PG8_LDA(At, 0, 1); PG8_STAGE(PG8_SB(0, 0), b2, voffB); PG8_STAGE(PG8_SB(0, 1), b2 + hstep, voffB); PG8_STAGE(PG8_SA(0, 0), a2, voffA);
            PG8_WAIT_V(8); PG8_WAIT_L(0); PG8_BAR; PG8_MMA(1, 0, At, B0); PG8_MMA(1, 1, At, B1); PG8_BAR; PG8_SCHED;
            PG8_LDB(B0, 1, 0); PG8_LDB(B1, 1, 1); PG8_SCHED; PG8_LDA(At, 1, 0); PG8_STAGE(PG8_SA(0, 1), a2 + hstep, voffA);
            PG8_WAIT_V(8); PG8_WAIT_L(0); PG8_BAR; PG8_MMA(0, 0, At, B0); PG8_MMA(0, 1, At, B1); PG8_BAR; PG8_SCHED;
            PG8_LDA(At, 1, 1); PG8_STAGE(PG8_SB(1, 0), b3, voffB); PG8_STAGE(PG8_SB(1, 1), b3 + hstep, voffB); PG8_STAGE(PG8_SA(1, 0), a3, voffA);
            PG8_WAIT_V(8); PG8_WAIT_L(0); PG8_BAR; PG8_MMA(1, 0, At, B0); PG8_MMA(1, 1, At, B1); PG8_BAR; PG8_SCHED;
            } else {
            PG8_LDB(B0, 0, 0); PG8_SCHED; PG8_LDA(At, 0, 0); PG8_STAGE(PG8_SA(1, 1), a1 + hstep, voffA);
            PG8_WAIT_L(8); PG8_BAR; PG8_WAIT_L(0); PG8_MMA(0, 0, At, B0); PG8_BAR; PG8_SCHED;
            PG8_LDB(B1, 0, 1); PG8_STAGE(PG8_SB(0, 0), b2, voffB);
            PG8_BAR; PG8_WAIT_L(0); PG8_MMA(0, 1, At, B1); PG8_BAR;
            PG8_LDA(At, 0, 1); PG8_STAGE(PG8_SA(0, 0), a2, voffA);
            PG8_BAR; PG8_WAIT_L(0); PG8_MMA(1, 0, At, B0); PG8_BAR; PG8_SCHED;
            PG8_STAGE(PG8_SB(0, 1), b2 + hstep, voffB);
            PG8_WAIT_V(6); PG8_BAR; PG8_MMA(1, 1, At, B1); PG8_BAR;
            PG8_LDB(B0, 1, 0); PG8_SCHED; PG8_LDA(At, 1, 0); PG8_STAGE(PG8_SA(0, 1), a2 + hstep, voffA);
            PG8_WAIT_L(8); PG8_BAR; PG8_WAIT_L(0); PG8_MMA(0, 0, At, B0); PG8_BAR; PG8_SCHED;
            PG8_LDB(B1, 1, 1); PG8_STAGE(PG8_SB(1, 0), b3, voffB);
            PG8_BAR; PG8_WAIT_L(0); PG8_MMA(0, 1, At, B1); PG8_BAR;
            PG8_LDA(At, 1, 1); PG8_STAGE(PG8_SA(1, 0), a3, voffA);
            PG8_BAR; PG8_WAIT_L(0); PG8_MMA(1, 0, At, B0); PG8_BAR; PG8_SCHED;
            PG8_STAGE(PG8_SB(1, 1), b3 + hstep, voffB);
            PG8_WAIT_V(6); PG8_BAR; PG8_MMA(1, 1, At, B1); PG8_BAR;
            }
        }
        if constexpr (ALIGN_EPI) { if (wr == 0) PG8_BAR; }
        if constexpr (!Epi::AFTER_DRAIN) { E(acc, cur, wr, wc, fr, fq); S.done(cur); }
        if (!has_next) break;
#pragma unroll
        for (int a = 0; a < 2; ++a)
#pragma unroll
            for (int b = 0; b < 2; ++b)
#pragma unroll
                for (int m = 0; m < 4; ++m)
#pragma unroll
                    for (int n = 0; n < 2; ++n) acc[a][b][m][n] = (f32x4){0.f, 0.f, 0.f, 0.f};
        cur = nxt; cA = nA; cB = nB; ++ui;
        if constexpr (ALIGN_EPI) { if (wr == 1) PG8_BAR; }
    }
    PG8_WAIT_V(0);
    if constexpr (!ALIGN_EPI) { if (wr == 0) PG8_BAR; }
    PG8_BAR;
    if constexpr (Epi::AFTER_DRAIN) { E.fused(acc, cur, wr, wc, fr, fq, lds, wid, lane); S.done(cur); }
#undef PG8_SA
#undef PG8_SB
#undef PG8_STAGE
#undef PG8_LDA
#undef PG8_LDB
#undef PG8_MMA
#undef PG8_WAIT_V
#undef PG8_WAIT_L
#undef PG8_BAR
#undef PG8_SCHED
}
}

constexpr int BATCH = 2, SEQ = 8192, DM = 1024, DFF = 2816, T = BATCH * SEQ;
constexpr int NIN = 4352;
constexpr float EPS = 1e-6f;
constexpr float LOG2E = 1.4426950408889634f;
constexpr float QS_MLA = 0.10206207261596575f * LOG2E;
constexpr float QS_DIL = 0.125f * LOG2E;

typedef unsigned short bf16;
typedef unsigned v4u __attribute__((ext_vector_type(4)));
typedef float f32x4 __attribute__((ext_vector_type(4)));
#define LAS __attribute__((address_space(3)))
#define LDS_WAIT() asm volatile("s_waitcnt lgkmcnt(0)" ::: "memory")

constexpr size_t MiB = 1u << 20;
constexpr size_t WS_CTL = 0;
constexpr size_t WS_WGU1 = 1 * MiB;
constexpr size_t WS_WD1 = WS_WGU1 + 11 * MiB;
constexpr size_t WS_WGU2 = WS_WD1 + 11 * MiB / 2;
constexpr size_t WS_WD2 = WS_WGU2 + 11 * MiB;
constexpr size_t WS_WIN = WS_WD2 + 11 * MiB / 2;
constexpr size_t WS_WUQ = WS_WIN + 17 * MiB / 2;
constexpr size_t WS_WUKV = WS_WUQ + 589824;
constexpr size_t WS_WA = WS_WUKV + 524288;
constexpr size_t WS_WB = WS_WA + 1 * MiB;
constexpr size_t WS_WO = WS_WB + 1 * MiB;
constexpr size_t WS_ROPEA = WS_WO + 2 * MiB;
constexpr size_t WS_ROPEB = WS_ROPEA + 2 * MiB;
constexpr size_t WS_SSQ = WS_ROPEB + 1 * MiB;
constexpr size_t WS_XN = 53 * MiB;
static_assert(WS_SSQ + (size_t)T * 20 * 4 <= WS_XN, "ws map");
constexpr size_t WS_R = 85 * MiB;
constexpr size_t WS_HMID = WS_R;
constexpr size_t WS_F = WS_R + 88 * MiB;
constexpr size_t WS_CQ = WS_R, WS_CKV = WS_R + 12 * MiB, WS_KR = WS_R + 20 * MiB, WS_DQ = WS_R + 24 * MiB, WS_DK = WS_R + 40 * MiB, WS_DV = WS_R + 56 * MiB,
                 WS_GT = WS_R + 72 * MiB, WS_KN = WS_R + 136 * MiB, WS_VA = WS_R + 152 * MiB, WS_END = WS_R + 168 * MiB;
constexpr size_t WS_Q = WS_XN;
constexpr size_t WS_OA = WS_CQ;
constexpr size_t WS_OB = WS_DQ;
constexpr size_t WS_MG = WS_KN;
constexpr size_t WS_F2 = WS_R;
static_assert(WS_END <= 256 * MiB, "ws map fits 256 MiB");

__device__ __forceinline__ unsigned f2bf(float f) { unsigned u = __builtin_bit_cast(unsigned, f); return (u + 0x7fffu + ((u >> 16) & 1u)) >> 16; }
__device__ __forceinline__ unsigned pk2(float lo, float hi) { return f2bf(lo) | (f2bf(hi) << 16); }
__device__ __forceinline__ float bf2f(unsigned short b) { return __uint_as_float((unsigned)b << 16); }
__device__ __forceinline__ float wave_sum(float v) {
#pragma unroll
    for (int o = 1; o < 64; o <<= 1) v += __shfl_xor(v, o);
    return v;
}

__device__ __forceinline__ void transpose_item(const float* W, int K, int N, bf16* WT, int k0, int n0, int drow0, const float* kscale, LAS float* scr, int lane) {
#pragma unroll 8
    for (int i = 0; i < 32; ++i) { const int kk = 2 * i + (lane >> 5); float w = W[(size_t)(k0 + kk) * N + n0 + (lane & 31)]; if (kscale) w *= kscale[k0 + kk]; scr[kk * 33 + (lane & 31)] = w; }
    LDS_WAIT(); asm volatile("" ::: "memory");
    const int c = lane & 7;
#pragma unroll
    for (int j = 0; j < 4; ++j) { const int n = (lane >> 3) + 8 * j; const LAS float* s = scr + (8 * c) * 33 + n;
        v4u o; o.x = pk2(s[0 * 33], s[1 * 33]); o.y = pk2(s[2 * 33], s[3 * 33]); o.z = pk2(s[4 * 33], s[5 * 33]); o.w = pk2(s[6 * 33], s[7 * 33]);
        *(v4u*)(WT + (size_t)(drow0 + n) * K + k0 + 8 * c) = o; }
    LDS_WAIT(); asm volatile("" ::: "memory");
}
struct ProArgs {
    const float* x; const int* pos; const float* g_pre1;
    const float *wg1, *wu1, *wd1, *wg2, *wu2, *wd2, *win, *wuq, *wuk, *wuv, *wa, *wb, *wo, *gq, *gkv;
    unsigned char* ws; float invA[16]; float invB[8];
};
__device__ __forceinline__ void rms_row_to_bf16(const float* xrow, const float* g, bf16* orow, int lane) {
    const f32x4* xr = (const f32x4*)xrow + lane; const f32x4* gr = (const f32x4*)g + lane;
    f32x4 v[4]; float s = 0.f;
#pragma unroll
    for (int j = 0; j < 4; ++j) { v[j] = xr[64 * j]; s += (v[j].x * v[j].x + v[j].y * v[j].y) + (v[j].z * v[j].z + v[j].w * v[j].w); }
    const float rstd = 1.0f / sqrtf(wave_sum(s) * (1.f / DM) + EPS);
    unsigned long long* o8 = (unsigned long long*)orow + lane;
#pragma unroll
    for (int j = 0; j < 4; ++j) { const f32x4 gg = gr[64 * j]; o8[64 * j] = (unsigned long long)pk2(v[j].x * rstd * gg.x, v[j].y * rstd * gg.y) | ((unsigned long long)pk2(v[j].z * rstd * gg.z, v[j].w * rstd * gg.w) << 32); }
}
__device__ __forceinline__ void sincos_acc(float angf, float& sn, float& cs) {
    const double a = (double)angf; const double k = rint(a * 0.63661977236758134308);
    const double r = fma(-k, 6.123233995736766e-17, fma(-k, 1.5707963267948966, a)); const double r2 = r * r;
    const double s = r * (1.0 + r2 * (-1.0 / 6 + r2 * (1.0 / 120 + r2 * (-1.0 / 5040 + r2 * (1.0 / 362880 + r2 * (-1.0 / 39916800))))));
    const double c = 1.0 + r2 * (-0.5 + r2 * (1.0 / 24 + r2 * (-1.0 / 720 + r2 * (1.0 / 40320 + r2 * (-1.0 / 3628800 + r2 * (1.0 / 479001600))))));
    const int q = ((int)k) & 3;
    const double ss = (q == 0) ? s : (q == 1) ? c : (q == 2) ? -s : -c; const double cc = (q == 0) ? c : (q == 1) ? -s : (q == 2) ? -c : s;
    sn = (float)ss; cs = (float)cc;
}
__device__ __forceinline__ void prologue_body(const ProArgs& a, LAS unsigned char* lds, int vcu, int G) {
    const int tid = threadIdx.x, lane = tid & 63, wave = __builtin_amdgcn_readfirstlane(tid >> 6);
    LAS float* scr = (LAS float*)(lds + wave * 16384);
    const int gw = vcu * 8 + wave, NGW = G * 8;
    unsigned char* ws = a.ws;
    constexpr int I_GU = 16 * 88, I_D = 44 * 32, I_IN = 16 * 133, I_UQ = 6 * 24, I_UK = 4 * 16, I_AB = 8 * 32, I_O = 16 * 32;
    constexpr int NITEMS = 6 * I_GU + I_IN + I_UQ + 2 * I_UK + 2 * I_AB + I_O;
    static_assert(I_D == I_GU, "item counts");
    for (int it = gw; it < NITEMS; it += NGW) {
        int r = it;
        if (r < 4 * I_GU) {
            const int which = r / I_GU; r -= which * I_GU; const int kb = r / 88, nb = r % 88, n0 = nb * 32;
            const float* W = which == 0 ? a.wg1 : which == 1 ? a.wu1 : which == 2 ? a.wg2 : a.wu2;
            bf16* WT = (bf16*)(ws + (which < 2 ? WS_WGU1 : WS_WGU2));
            transpose_item(W, DM, DFF, WT, kb * 64, n0, 256 * (n0 >> 7) + 128 * (which & 1) + (n0 & 127), nullptr, scr, lane); continue; }
        r -= 4 * I_GU;
        if (r < 2 * I_D) { const int which = r / I_D; r -= which * I_D; const int kb = r / 32, nb = r % 32;
            transpose_item(which ? a.wd2 : a.wd1, DFF, DM, (bf16*)(ws + (which ? WS_WD2 : WS_WD1)), kb * 64, nb * 32, nb * 32, nullptr, scr, lane); continue; }
        r -= 2 * I_D;
        if (r < I_IN) { const int kb = r / 133, nb = r % 133, n0 = nb * 32;
            transpose_item(a.win, DM, 4256, (bf16*)(ws + WS_WIN), kb * 64, n0, n0 < 672 ? n0 : n0 + 96, nullptr, scr, lane); continue; }
        r -= I_IN;
        if (r < I_UQ) { const int kb = r / 24, nb = r % 24; transpose_item(a.wuq, 384, 768, (bf16*)(ws + WS_WUQ), kb * 64, nb * 32, nb * 32, a.gq, scr, lane); continue; }
        r -= I_UQ;
        if (r < 2 * I_UK) { const int which = r / I_UK; r -= which * I_UK; const int kb = r / 16, nb = r % 16;
            transpose_item(which ? a.wuv : a.wuk, 256, 512, (bf16*)(ws + WS_WUKV), kb * 64, nb * 32, which * 512 + nb * 32, a.gkv, scr, lane); continue; }
        r -= 2 * I_UK;
        if (r < 2 * I_AB) { const int which = r / I_AB; r -= which * I_AB; const int kb = r / 32, nb = r % 32;
            transpose_item(which ? a.wb : a.wa, 512, DM, (bf16*)(ws + (which ? WS_WB : WS_WA)), kb * 64, nb * 32, nb * 32, nullptr, scr, lane); continue; }
        r -= 2 * I_AB;
        { const int kb = r / 32, nb = r % 32; transpose_item(a.wo, DM, DM, (bf16*)(ws + WS_WO), kb * 64, nb * 32, nb * 32, nullptr, scr, lane); }
    }
    { const int gt = vcu * 512 + tid; if (gt < 12288) ((v4u*)(ws + WS_WIN + (size_t)672 * 2048))[gt] = (v4u){0u, 0u, 0u, 0u}; }
    for (int m = gw; m < T; m += NGW) rms_row_to_bf16(a.x + (size_t)m * DM, a.g_pre1, (bf16*)(ws + WS_XN) + (size_t)m * DM, lane);
    for (int i = vcu * 512 + tid; i < T * 24; i += G * 512) {
        const int row = i / 24, f = i % 24; const float p = (float)a.pos[row];
        float sn, cs;
        if (f < 16) { sincos_acc(p * a.invA[f], sn, cs); float* o = (float*)(ws + WS_ROPEA) + (size_t)row * 32; o[f] = cs; o[16 + f] = sn; }
        else { sincos_acc(p * a.invB[f - 16], sn, cs); float* o = (float*)(ws + WS_ROPEB) + (size_t)row * 16; o[f - 16] = cs; o[8 + f - 16] = sn; }
    }
}
__global__ void __launch_bounds__(512, 2) prologue_k(ProArgs a) {
    extern __shared__ __attribute__((aligned(16))) unsigned char lds[];
    const int G = gridDim.x, bx = blockIdx.x; const int vcu = (G % 8 == 0) ? (bx % 8) * (G / 8) + bx / 8 : bx;
    prologue_body(a, (LAS unsigned char*)lds, vcu, G);
}

template <class Epi, bool ALIGN>
__global__ void __launch_bounds__(512, 2) gemm_k(pg8::Gemm g, Epi E) {
    extern __shared__ __attribute__((aligned(16))) unsigned char lds[];
    pg8::StaticOrder S; S.init(g.M, g.N, gridDim.x, (int)blockIdx.x);
    pg8::gemm_phase<Epi, pg8::StaticOrder, ALIGN, true>((PG8_LAS unsigned char*)lds, g, S, E);
}

template <bool XN>
__global__ void __launch_bounds__(512) norm_res_k(const float* base, const float* F, const float* g1, float coef, float* out, const float* g2, bf16* xn) {
    const int lane = threadIdx.x & 63, gw = blockIdx.x * 8 + (threadIdx.x >> 6), NGW = gridDim.x * 8;
    for (int m = gw; m < T; m += NGW) {
        const f32x4* fr = (const f32x4*)(F + (size_t)m * DM) + lane; const f32x4* br = (const f32x4*)(base + (size_t)m * DM) + lane;
        f32x4 f[4], h[4]; float s = 0.f;
#pragma unroll
        for (int j = 0; j < 4; ++j) { f[j] = fr[64 * j]; h[j] = br[64 * j]; s += (f[j].x * f[j].x + f[j].y * f[j].y) + (f[j].z * f[j].z + f[j].w * f[j].w); }
        const float rs = coef / sqrtf(wave_sum(s) * (1.f / DM) + EPS); float s2 = 0.f;
#pragma unroll
        for (int j = 0; j < 4; ++j) { const f32x4 gg = ((const f32x4*)g1 + lane)[64 * j]; h[j] = h[j] + f[j] * rs * gg; s2 += (h[j].x * h[j].x + h[j].y * h[j].y) + (h[j].z * h[j].z + h[j].w * h[j].w); }
        f32x4* orow = (f32x4*)(out + (size_t)m * DM) + lane;
#pragma unroll
        for (int j = 0; j < 4; ++j) orow[64 * j] = h[j];
        if (XN) {
            const float r2 = 1.0f / sqrtf(wave_sum(s2) * (1.f / DM) + EPS);
            unsigned long long* o8 = (unsigned long long*)(xn + (size_t)m * DM) + lane;
#pragma unroll
            for (int j = 0; j < 4; ++j) { const f32x4 gg = ((const f32x4*)g2 + lane)[64 * j];
                o8[64 * j] = (unsigned long long)pk2(h[j].x * r2 * gg.x, h[j].y * r2 * gg.y) | ((unsigned long long)pk2(h[j].z * r2 * gg.z, h[j].w * r2 * gg.w) << 32); }
        }
    }
}

__global__ void __launch_bounds__(256) mla_naive_k(const bf16* Q, const bf16* KN, const bf16* KR, const bf16* VA, bf16* OA) {
    __shared__ float Ks[32][96]; __shared__ float Vs[32][64];
    const int bh = blockIdx.x >> 5, qb = blockIdx.x & 31, b = bh >> 3, h = bh & 7, tid = threadIdx.x;
    const size_t t = (size_t)b * SEQ + qb * 256 + tid;
    float q[96], o[64];
#pragma unroll
    for (int c = 0; c < 12; ++c) { const v4u w = *(const v4u*)(Q + t * 768 + h * 96 + c * 8);
        q[c * 8 + 0] = pg8::bf_lo(w.x); q[c * 8 + 1] = pg8::bf_hi(w.x); q[c * 8 + 2] = pg8::bf_lo(w.y); q[c * 8 + 3] = pg8::bf_hi(w.y);
        q[c * 8 + 4] = pg8::bf_lo(w.z); q[c * 8 + 5] = pg8::bf_hi(w.z); q[c * 8 + 6] = pg8::bf_lo(w.w); q[c * 8 + 7] = pg8::bf_hi(w.w); }
#pragma unroll
    for (int d = 0; d < 64; ++d) o[d] = 0.f;
    float m = -1e30f, l = 0.f;
    const int key = tid >> 3, part = tid & 7;
    for (int kt = 0; kt < SEQ / 32; ++kt) {
        __syncthreads();
        { const size_t kr = (size_t)b * SEQ + kt * 32 + key;
            const v4u w = *(const v4u*)(KN + kr * 512 + h * 64 + part * 8);
            float* d = &Ks[key][part * 8];
            d[0] = pg8::bf_lo(w.x); d[1] = pg8::bf_hi(w.x); d[2] = pg8::bf_lo(w.y); d[3] = pg8::bf_hi(w.y); d[4] = pg8::bf_lo(w.z); d[5] = pg8::bf_hi(w.z); d[6] = pg8::bf_lo(w.w); d[7] = pg8::bf_hi(w.w);
            const v4u v = *(const v4u*)(VA + kr * 512 + h * 64 + part * 8);
            float* e = &Vs[key][part * 8];
            e[0] = pg8::bf_lo(v.x); e[1] = pg8::bf_hi(v.x); e[2] = pg8::bf_lo(v.y); e[3] = pg8::bf_hi(v.y); e[4] = pg8::bf_lo(v.z); e[5] = pg8::bf_hi(v.z); e[6] = pg8::bf_lo(v.w); e[7] = pg8::bf_hi(v.w);
            if (part < 4) { const v4u r = *(const v4u*)(KR + kr * 32 + part * 8); float* g = &Ks[key][64 + part * 8];
                g[0] = pg8::bf_lo(r.x); g[1] = pg8::bf_hi(r.x); g[2] = pg8::bf_lo(r.y); g[3] = pg8::bf_hi(r.y); g[4] = pg8::bf_lo(r.z); g[5] = pg8::bf_hi(r.z); g[6] = pg8::bf_lo(r.w); g[7] = pg8::bf_hi(r.w); } }
        __syncthreads();
        for (int k = 0; k < 32; ++k) {
            float s = 0.f;
#pragma unroll
            for (int d = 0; d < 96; ++d) s += q[d] * Ks[k][d];
            const float mn = fmaxf(m, s), al = __builtin_amdgcn_exp2f(m - mn), p = __builtin_amdgcn_exp2f(s - mn);
            l = l * al + p; m = mn;
#pragma unroll
            for (int d = 0; d < 64; ++d) o[d] = o[d] * al + p * Vs[k][d];
        }
    }
    const float il = 1.0f / l;
#pragma unroll
    for (int c = 0; c < 8; ++c) { v4u w; w.x = pk2(o[c * 8 + 0] * il, o[c * 8 + 1] * il); w.y = pk2(o[c * 8 + 2] * il, o[c * 8 + 3] * il); w.z = pk2(o[c * 8 + 4] * il, o[c * 8 + 5] * il); w.w = pk2(o[c * 8 + 6] * il, o[c * 8 + 7] * il);
        *(v4u*)(OA + t * 512 + h * 64 + c * 8) = w; }
}
__global__ void __launch_bounds__(256) dil_naive_k(const bf16* DQ, const bf16* DK, const bf16* DV, bf16* OB) {
    const int idx = blockIdx.x * 256 + threadIdx.x; const int s = idx & (SEQ - 1), bh = idx >> 13, b = bh >> 3, h = bh & 7;
    const size_t t = (size_t)b * SEQ + s;
    float q[64], o[64];
#pragma unroll
    for (int c = 0; c < 8; ++c) { const v4u w = *(const v4u*)(DQ + t * 512 + h * 64 + c * 8);
        q[c * 8 + 0] = pg8::bf_lo(w.x); q[c * 8 + 1] = pg8::bf_hi(w.x); q[c * 8 + 2] = pg8::bf_lo(w.y); q[c * 8 + 3] = pg8::bf_hi(w.y);
        q[c * 8 + 4] = pg8::bf_lo(w.z); q[c * 8 + 5] = pg8::bf_hi(w.z); q[c * 8 + 6] = pg8::bf_lo(w.w); q[c * 8 + 7] = pg8::bf_hi(w.w); }
#pragma unroll
    for (int d = 0; d < 64; ++d) o[d] = 0.f;
    float m = -1e30f, l = 0.f;
    for (int pat = 0; pat < 3; ++pat) {
        const int dil = pat == 0 ? 1 : pat == 1 ? 4 : 16;
        for (int j = -64; j <= 64; ++j) {
            const int sk = s + j * dil; if (sk < 0 || sk >= SEQ) continue;
            const size_t kr = ((size_t)b * SEQ + sk) * 512 + h * 64;
            float sc = 0.f;
#pragma unroll
            for (int c = 0; c < 8; ++c) { const v4u w = *(const v4u*)(DK + kr + c * 8);
                sc += q[c * 8 + 0] * pg8::bf_lo(w.x) + q[c * 8 + 1] * pg8::bf_hi(w.x) + q[c * 8 + 2] * pg8::bf_lo(w.y) + q[c * 8 + 3] * pg8::bf_hi(w.y)
                    + q[c * 8 + 4] * pg8::bf_lo(w.z) + q[c * 8 + 5] * pg8::bf_hi(w.z) + q[c * 8 + 6] * pg8::bf_lo(w.w) + q[c * 8 + 7] * pg8::bf_hi(w.w); }
            const float mn = fmaxf(m, sc), al = __builtin_amdgcn_exp2f(m - mn), p = __builtin_amdgcn_exp2f(sc - mn);
            l = l * al + p; m = mn;
#pragma unroll
            for (int c = 0; c < 8; ++c) { const v4u w = *(const v4u*)(DV + kr + c * 8);
                o[c * 8 + 0] = o[c * 8 + 0] * al + p * pg8::bf_lo(w.x); o[c * 8 + 1] = o[c * 8 + 1] * al + p * pg8::bf_hi(w.x);
                o[c * 8 + 2] = o[c * 8 + 2] * al + p * pg8::bf_lo(w.y); o[c * 8 + 3] = o[c * 8 + 3] * al + p * pg8::bf_hi(w.y);
                o[c * 8 + 4] = o[c * 8 + 4] * al + p * pg8::bf_lo(w.z); o[c * 8 + 5] = o[c * 8 + 5] * al + p * pg8::bf_hi(w.z);
                o[c * 8 + 6] = o[c * 8 + 6] * al + p * pg8::bf_lo(w.w); o[c * 8 + 7] = o[c * 8 + 7] * al + p * pg8::bf_hi(w.w); }
        }
    }
    const float il = 1.0f / l;
#pragma unroll
    for (int c = 0; c < 8; ++c) { v4u w; w.x = pk2(o[c * 8 + 0] * il, o[c * 8 + 1] * il); w.y = pk2(o[c * 8 + 2] * il, o[c * 8 + 3] * il); w.z = pk2(o[c * 8 + 4] * il, o[c * 8 + 5] * il); w.w = pk2(o[c * 8 + 6] * il, o[c * 8 + 7] * il);
        *(v4u*)(OB + t * 512 + h * 64 + c * 8) = w; }
}

template <class Epi, bool ALIGN> static void launch_gemm(const bf16* A, const bf16* Bt, int N, int K, const Epi& E, hipStream_t stream) {
    static bool attr = false;
    if (!attr) { (void)hipFuncSetAttribute((const void*)gemm_k<Epi, ALIGN>, hipFuncAttributeMaxDynamicSharedMemorySize, 131072); attr = true; }
    pg8::Gemm g{A, Bt, T, N, K, 0};
    hipLaunchKernelGGL((gemm_k<Epi, ALIGN>), dim3(256), dim3(512), 131072, stream, g, E);
}
extern "C" void kernel_launch(void* const* d_in, const int* in_sizes, int n_in, void* d_out, int out_size, void* d_ws, size_t ws_size, hipStream_t stream) {
    if (n_in != 24 || in_sizes[0] != T * DM || out_size != T * DM || ws_size < WS_END) { fprintf(stderr, "kernel_launch: unexpected shapes / workspace (%d inputs, ws %zu)\n", n_in, ws_size); return; }
    unsigned char* ws = (unsigned char*)d_ws;
    const float* x = (const float*)d_in[0];
    float* out = (float*)d_out;
    static bool init = false;
    if (!init) { (void)hipFuncSetAttribute((const void*)prologue_k, hipFuncAttributeMaxDynamicSharedMemorySize, 131072); init = true; }
    ProArgs pa{};
    pa.x = x; pa.pos = (const int*)d_in[1]; pa.g_pre1 = (const float*)d_in[2];
    pa.wg1 = (const float*)d_in[4]; pa.wu1 = (const float*)d_in[5]; pa.wd1 = (const float*)d_in[6];
    pa.wg2 = (const float*)d_in[21]; pa.wu2 = (const float*)d_in[22]; pa.wd2 = (const float*)d_in[23];
    pa.win = (const float*)d_in[8]; pa.wuq = (const float*)d_in[11]; pa.wuk = (const float*)d_in[13]; pa.wuv = (const float*)d_in[14];
    pa.wa = (const float*)d_in[15]; pa.wb = (const float*)d_in[16]; pa.wo = (const float*)d_in[17]; pa.gq = (const float*)d_in[10]; pa.gkv = (const float*)d_in[12];
    pa.ws = ws;
    for (int i = 0; i < 16; ++i) pa.invA[i] = 1.0f / powf(10000.0f, (float)i / 16.0f);
    for (int i = 0; i < 8; ++i) pa.invB[i] = 1.0f / powf(500000.0f, (float)i / 8.0f);
    hipLaunchKernelGGL(prologue_k, dim3(256), dim3(512), 131072, stream, pa);

    bf16* XN = (bf16*)(ws + WS_XN); bf16* HMID = (bf16*)(ws + WS_HMID); float* F = (float*)(ws + WS_F); float* F2 = (float*)(ws + WS_F2);
    float* ropeA = (float*)(ws + WS_ROPEA); float* ropeB = (float*)(ws + WS_ROPEB); float* SSQ = (float*)(ws + WS_SSQ);
    launch_gemm<pg8::EpiSwiGLU, true>(XN, (const bf16*)(ws + WS_WGU1), 2 * DFF, DM, pg8::EpiSwiGLU{HMID, DFF, 0}, stream);
    launch_gemm<pg8::EpiF32, false>(HMID, (const bf16*)(ws + WS_WD1), DM, DFF, pg8::EpiF32{F, DM, 0}, stream);
    hipLaunchKernelGGL(norm_res_k<true>, dim3(1024), dim3(512), 0, stream, x, (const float*)F, (const float*)d_in[3], 0.5f, out, (const float*)d_in[7], XN);
    { pg8::EpiInProj E{(bf16*)(ws + WS_CQ), (bf16*)(ws + WS_CKV), (bf16*)(ws + WS_KR), (bf16*)(ws + WS_DQ), (bf16*)(ws + WS_DK), (bf16*)(ws + WS_DV), (bf16*)(ws + WS_GT), SSQ,
                       (const float*)d_in[9], ropeA, ropeB, QS_DIL, 0};
      launch_gemm<pg8::EpiInProj, true>(XN, (const bf16*)(ws + WS_WIN), NIN, DM, E, stream); }
    launch_gemm<pg8::EpiQUp, true>((const bf16*)(ws + WS_CQ), (const bf16*)(ws + WS_WUQ), 768, 384, pg8::EpiQUp{(bf16*)(ws + WS_Q), SSQ, ropeA, QS_MLA, EPS}, stream);
    launch_gemm<pg8::EpiKVUp, true>((const bf16*)(ws + WS_CKV), (const bf16*)(ws + WS_WUKV), 1024, 256, pg8::EpiKVUp{(bf16*)(ws + WS_KN), (bf16*)(ws + WS_VA), SSQ, EPS, 0}, stream);
    hipLaunchKernelGGL(dil_naive_k, dim3(T * 8 / 256), dim3(256), 0, stream, (const bf16*)(ws + WS_DQ), (const bf16*)(ws + WS_DK), (const bf16*)(ws + WS_DV), (bf16*)(ws + WS_OB));
    hipLaunchKernelGGL(mla_naive_k, dim3(16 * 32), dim3(256), 0, stream, (const bf16*)(ws + WS_Q), (const bf16*)(ws + WS_KN), (const bf16*)(ws + WS_KR), (const bf16*)(ws + WS_VA), (bf16*)(ws + WS_OA));
    launch_gemm<pg8::EpiGate<true>, true>((const bf16*)(ws + WS_OA), (const bf16*)(ws + WS_WA), DM, 512, pg8::EpiGate<true>{(bf16*)(ws + WS_MG), (const bf16*)(ws + WS_GT)}, stream);
    launch_gemm<pg8::EpiGate<false>, true>((const bf16*)(ws + WS_OB), (const bf16*)(ws + WS_WB), DM, 512, pg8::EpiGate<false>{(bf16*)(ws + WS_MG), (const bf16*)(ws + WS_GT)}, stream);
    launch_gemm<pg8::EpiF32, false>((const bf16*)(ws + WS_MG), (const bf16*)(ws + WS_WO), DM, DM, pg8::EpiF32{F2, DM, 0}, stream);
    hipLaunchKernelGGL(norm_res_k<true>, dim3(1024), dim3(512), 0, stream, (const float*)out, (const float*)F2, (const float*)d_in[18], 1.0f, out, (const float*)d_in[19], XN);
    launch_gemm<pg8::EpiSwiGLU, true>(XN, (const bf16*)(ws + WS_WGU2), 2 * DFF, DM, pg8::EpiSwiGLU{HMID, DFF, 0}, stream);
    launch_gemm<pg8::EpiF32, false>(HMID, (const bf16*)(ws + WS_WD2), DM, DFF, pg8::EpiF32{F, DM, 0}, stream);
    hipLaunchKernelGGL(norm_res_k<false>, dim3(1024), dim3(512), 0, stream, (const float*)out, (const float*)F, (const float*)d_in[20], 0.5f, out, (const float*)nullptr, (bf16*)nullptr);
}
```

```cpp
#include <hip/hip_runtime.h>
#include <cstdio>
#include <cstdint>
#include <cmath>
namespace pg8 {
#define PG8_LAS __attribute__((address_space(3)))
typedef unsigned short bf16_t;
typedef short bf16x8 __attribute__((ext_vector_type(8)));
typedef float f32x4 __attribute__((ext_vector_type(4)));
typedef unsigned u32x4 __attribute__((ext_vector_type(4)));
constexpr int BM = 256, BK = 64, HALF = 128, HTB = HALF * BK * 2  , STAGE_BYTES = 8 * HTB, NXCD = 8, WGM = 8;

__host__ __device__ __forceinline__ int lds_byte(int r, int c) { const int st = (r >> 4) * 2 + (c >> 5), rr = r & 15, cc = c & 31, ob = rr * 64 + cc * 2; return st * 1024 + (ob ^ (((ob >> 9) & 1) << 5)); }
__host__ __device__ __forceinline__ void stage_rc(int b, int& R, int& C) { const int st = b / 1024, sb = b % 1024, swz = sb ^ (((sb >> 9) & 1) << 5); R = (st >> 1) * 16 + swz / 64; C = (st & 1) * 32 + (swz % 64) / 2; }
__host__ __device__ __forceinline__ int perm32(int rho) { const int n = rho >> 4, i = rho & 15; return 8 * (i >> 2) + 4 * n + (i & 3); }

struct Unit { int pm, pn; };
struct Gemm { const bf16_t* A; const bf16_t* Bt; int M, N, K, pad; };

struct StaticOrder {
    int nM, nN, nwg, G, c;
    __host__ __device__ void init(int M, int N, int G_, int c_) { nM = M / BM; nN = N / BM; nwg = nM * nN; G = G_; c = c_; }
    __host__ __device__ bool next(int i, Unit& u) const {
        const long L = (long)i * G + c; if (L >= nwg) return false;
        int wgid = (int)L; { const int q = nwg / NXCD, r = nwg % NXCD, xcd = wgid % NXCD, off = wgid / NXCD; wgid = (xcd < r ? xcd * (q + 1) : r * (q + 1) + (xcd - r) * q) + off; }
        const int nig = WGM * nN, gid = wgid / nig, fm = gid * WGM, gsz = (nM - fm) < WGM ? (nM - fm) : WGM;
        u.pm = fm + ((wgid % nig) % gsz); u.pn = (wgid % nig) / gsz; return true;
    }
    __device__ __forceinline__ void a_ready(const Unit&) const {}
    __device__ __forceinline__ void done(const Unit&) const {}
};

__device__ __forceinline__ unsigned cvt_pk_bf16(float lo, float hi) { unsigned r; asm volatile("v_cvt_pk_bf16_f32 %0, %1, %2" : "=v"(r) : "v"(lo), "v"(hi)); return r; }
__device__ __forceinline__ float bf_lo(unsigned w) { return __uint_as_float(w << 16); }
__device__ __forceinline__ float bf_hi(unsigned w) { return __uint_as_float(w & 0xffff0000u); }
__device__ __forceinline__ float sigm(float x) { return __builtin_amdgcn_rcpf(1.0f + __builtin_amdgcn_exp2f(-1.4426950408889634f * x)); }
__device__ __forceinline__ u32x4 pack8(const float (&v)[8]) { u32x4 w; w.x = cvt_pk_bf16(v[0], v[1]); w.y = cvt_pk_bf16(v[2], v[3]); w.z = cvt_pk_bf16(v[4], v[5]); w.w = cvt_pk_bf16(v[6], v[7]); return w; }

struct EpiF32 {
    static constexpr bool PERM = false, AFTER_DRAIN = false;
    float* C; int ldc; int pad;
    __device__ __forceinline__ void operator()(const f32x4 (&acc)[2][2][4][2], const Unit& u, int wr, int wc, int fr, int fq) const {
        const int row0 = u.pm * BM + wr * 64 + fr, col0 = u.pn * BM + wc * 32 + 4 * fq;
#pragma unroll
        for (int ai = 0; ai < 2; ++ai)
#pragma unroll
            for (int m = 0; m < 4; ++m) { float* rowp = C + (size_t)(row0 + ai * HALF + m * 16) * ldc + col0;
#pragma unroll
                for (int bj = 0; bj < 2; ++bj)
#pragma unroll
                    for (int n = 0; n < 2; ++n) *(f32x4*)(rowp + bj * HALF + n * 16) = acc[ai][bj][m][n]; }
    }
};

struct EpiSwiGLU {
    static constexpr bool PERM = true, AFTER_DRAIN = false;
    bf16_t* O; int ldc; int pad;
    __device__ __forceinline__ void operator()(const f32x4 (&acc)[2][2][4][2], const Unit& u, int wr, int wc, int fr, int fq) const {
        const int row0 = u.pm * BM + wr * 64 + fr, col0 = u.pn * HALF + wc * 32 + 8 * fq;
#pragma unroll
        for (int ai = 0; ai < 2; ++ai)
#pragma unroll
            for (int m = 0; m < 4; ++m) { bf16_t* rowp = O + (size_t)(row0 + ai * HALF + m * 16) * ldc + col0;
                float o[8];
#pragma unroll
                for (int n = 0; n < 2; ++n)
#pragma unroll
                    for (int i = 0; i < 4; ++i) { const float g = acc[ai][0][m][n][i], up = acc[ai][1][m][n][i]; o[4 * n + i] = g * sigm(g) * up; }
                *(u32x4*)rowp = pack8(o); }
    }
};

struct EpiInProj {
    static constexpr bool PERM = true, AFTER_DRAIN = false;
    bf16_t *CQ, *CKV, *KR, *DQ, *DK, *DV, *GT; float* SSQ; const float* bgate; const float* ropeA; const float* ropeB; float qscale; int pad;
    __device__ __forceinline__ void operator()(const f32x4 (&acc)[2][2][4][2], const Unit& u, int wr, int wc, int fr, int fq) const {
        const int row0 = u.pm * BM + wr * 64 + fr;
#pragma unroll
        for (int bj = 0; bj < 2; ++bj) {
            const int G = u.pn * 8 + bj * 4 + wc;
            if (G >= 21 && G < 24) continue;
            f32x4 b0 = (f32x4){0.f, 0.f, 0.f, 0.f}, b1 = b0;
            if (G >= 72) { const float* bp = bgate + (G - 72) * 32 + 8 * fq; b0 = *(const f32x4*)bp; b1 = *(const f32x4*)(bp + 4); }
#pragma unroll
            for (int ai = 0; ai < 2; ++ai)
#pragma unroll
                for (int m = 0; m < 4; ++m) {
                    const int row = row0 + ai * HALF + m * 16;
                    float v[8];
#pragma unroll
                    for (int i = 0; i < 4; ++i) { v[i] = acc[ai][bj][m][0][i]; v[4 + i] = acc[ai][bj][m][1][i]; }
                    if (G < 20) {
                        float ss = 0.f;
#pragma unroll
                        for (int i = 0; i < 8; ++i) ss += v[i] * v[i];
                        ss += __shfl_xor(ss, 16); ss += __shfl_xor(ss, 32);
                        if (fq == 0) SSQ[(size_t)row * 20 + G] = ss;
                        bf16_t* dst = (G < 12) ? CQ + (size_t)row * 384 + G * 32 + 8 * fq : CKV + (size_t)row * 256 + (G - 12) * 32 + 8 * fq;
                        *(u32x4*)dst = pack8(v);
                    } else if (G == 20) {
                        const float* rp = ropeA + (size_t)row * 32 + 8 * (fq & 1);
                        const f32x4 c0 = *(const f32x4*)rp, c1 = *(const f32x4*)(rp + 4), s0 = *(const f32x4*)(rp + 16), s1 = *(const f32x4*)(rp + 20);
                        float o[8];
#pragma unroll
                        for (int i = 0; i < 8; ++i) { const float p = __shfl_xor(v[i], 32); const float c = i < 4 ? c0[i] : c1[i - 4], s = i < 4 ? s0[i] : s1[i - 4];
                            o[i] = (fq < 2) ? v[i] * c - p * s : v[i] * c + p * s; }
                        *(u32x4*)(KR + (size_t)row * 32 + 8 * fq) = pack8(o);
                    } else if (G < 56) {
                        const bool isq = G < 40; const int g2 = isq ? G - 24 : G - 40;
                        float o[8];
                        if ((g2 & 1) == 0) {
                            const float* rp = ropeB + (size_t)row * 16;
                            const f32x4 c0 = *(const f32x4*)rp, c1 = *(const f32x4*)(rp + 4), s0 = *(const f32x4*)(rp + 8), s1 = *(const f32x4*)(rp + 12);
#pragma unroll
                            for (int i = 0; i < 8; ++i) { const float p = __shfl_xor(v[i], 16); const float c = i < 4 ? c0[i] : c1[i - 4], s = i < 4 ? s0[i] : s1[i - 4];
                                o[i] = (fq == 0) ? v[i] * c - p * s : (fq == 1) ? v[i] * c + p * s : v[i]; }
                        } else {
#pragma unroll
                            for (int i = 0; i < 8; ++i) o[i] = v[i];
                        }
                        if (isq) {
#pragma unroll
                            for (int i = 0; i < 8; ++i) o[i] *= qscale;
                        }
                        bf16_t* dst = (isq ? DQ : DK) + (size_t)row * 512 + g2 * 32 + 8 * fq;
                        *(u32x4*)dst = pack8(o);
                    } else if (G < 72) {
                        *(u32x4*)(DV + (size_t)row * 512 + (G - 56) * 32 + 8 * fq) = pack8(v);
                    } else {
                        float o[8];
#pragma unroll
                        for (int i = 0; i < 4; ++i) { o[i] = sigm(v[i] + b0[i]); o[4 + i] = sigm(v[4 + i] + b1[i]); }
                        *(u32x4*)(GT + (size_t)row * 2048 + (G - 72) * 32 + 8 * fq) = pack8(o);
                    }
                }
        }
    }
};

struct EpiQUp {
    static constexpr bool PERM = true, AFTER_DRAIN = false;
    bf16_t* Q; const float* SSQ; const float* ropeA; float qscale; float eps;
    __device__ __forceinline__ void operator()(const f32x4 (&acc)[2][2][4][2], const Unit& u, int wr, int wc, int fr, int fq) const {
        const int row0 = u.pm * BM + wr * 64 + fr;
#pragma unroll
        for (int ai = 0; ai < 2; ++ai)
#pragma unroll
            for (int m = 0; m < 4; ++m) {
                const int row = row0 + ai * HALF + m * 16;
                const float* sp = SSQ + (size_t)row * 20;
                const f32x4 a = *(const f32x4*)sp, b = *(const f32x4*)(sp + 4), c = *(const f32x4*)(sp + 8);
                const float ss = ((a[0] + a[1]) + (a[2] + a[3])) + ((b[0] + b[1]) + (b[2] + b[3])) + ((c[0] + c[1]) + (c[2] + c[3]));
                const float rs = __builtin_amdgcn_rsqf(ss * (1.0f / 384.0f) + eps) * qscale;
#pragma unroll
                for (int bj = 0; bj < 2; ++bj) {
                    const int G = u.pn * 8 + bj * 4 + wc;
                    float v[8];
#pragma unroll
                    for (int i = 0; i < 4; ++i) { v[i] = acc[ai][bj][m][0][i] * rs; v[4 + i] = acc[ai][bj][m][1][i] * rs; }
                    if (G % 3 == 2) {
                        const float* rp = ropeA + (size_t)row * 32 + 8 * (fq & 1);
                        const f32x4 c0 = *(const f32x4*)rp, c1 = *(const f32x4*)(rp + 4), s0 = *(const f32x4*)(rp + 16), s1 = *(const f32x4*)(rp + 20);
#pragma unroll
                        for (int i = 0; i < 8; ++i) { const float p = __shfl_xor(v[i], 32); const float cc = i < 4 ? c0[i] : c1[i - 4], s = i < 4 ? s0[i] : s1[i - 4];
                            v[i] = (fq < 2) ? v[i] * cc - p * s : v[i] * cc + p * s; }
                    }
                    *(u32x4*)(Q + (size_t)row * 768 + G * 32 + 8 * fq) = pack8(v);
                }
            }
    }
};

struct EpiKVUp {
    static constexpr bool PERM = true, AFTER_DRAIN = false;
    bf16_t *KN, *VA; const float* SSQ; float eps; int pad;
    __device__ __forceinline__ void operator()(const f32x4 (&acc)[2][2][4][2], const Unit& u, int wr, int wc, int fr, int fq) const {
        const int row0 = u.pm * BM + wr * 64 + fr;
#pragma unroll
        for (int ai = 0; ai < 2; ++ai)
#pragma unroll
            for (int m = 0; m < 4; ++m) {
                const int row = row0 + ai * HALF + m * 16;
                const float* sp = SSQ + (size_t)row * 20 + 12;
                const f32x4 a = *(const f32x4*)sp, b = *(const f32x4*)(sp + 4);
                const float ss = ((a[0] + a[1]) + (a[2] + a[3])) + ((b[0] + b[1]) + (b[2] + b[3]));
                const float rs = __builtin_amdgcn_rsqf(ss * (1.0f / 256.0f) + eps);
#pragma unroll
                for (int bj = 0; bj < 2; ++bj) {
                    const int c = u.pn * BM + bj * HALF + wc * 32 + 8 * fq;
                    float v[8];
#pragma unroll
                    for (int i = 0; i < 4; ++i) { v[i] = acc[ai][bj][m][0][i] * rs; v[4 + i] = acc[ai][bj][m][1][i] * rs; }
                    bf16_t* dst = (c < 512) ? KN + (size_t)row * 512 + c : VA + (size_t)row * 512 + (c - 512);
                    *(u32x4*)dst = pack8(v);
                }
            }
    }
};

template <bool FIRST> struct EpiGate {
    static constexpr bool PERM = true, AFTER_DRAIN = false;
    bf16_t* MG; const bf16_t* GT;
    __device__ __forceinline__ void operator()(const f32x4 (&acc)[2][2][4][2], const Unit& u, int wr, int wc, int fr, int fq) const {
        const int row0 = u.pm * BM + wr * 64 + fr, col0 = u.pn * BM + wc * 32 + 8 * fq;
#pragma unroll
        for (int ai = 0; ai < 2; ++ai)
#pragma unroll
            for (int m = 0; m < 4; ++m) {
                const int row = row0 + ai * HALF + m * 16;
#pragma unroll
                for (int bj = 0; bj < 2; ++bj) {
                    const int c = col0 + bj * HALF;
                    const u32x4 gw = *(const u32x4*)(GT + (size_t)row * 2048 + (FIRST ? 0 : 1024) + c);
                    float v[8];
#pragma unroll
                    for (int i = 0; i < 4; ++i) { v[i] = acc[ai][bj][m][0][i]; v[4 + i] = acc[ai][bj][m][1][i]; }
                    v[0] *= bf_lo(gw.x); v[1] *= bf_hi(gw.x); v[2] *= bf_lo(gw.y); v[3] *= bf_hi(gw.y); v[4] *= bf_lo(gw.z); v[5] *= bf_hi(gw.z); v[6] *= bf_lo(gw.w); v[7] *= bf_hi(gw.w);
                    bf16_t* dst = MG + (size_t)row * 1024 + c;
                    if (!FIRST) { const u32x4 pw = *(const u32x4*)dst;
                        v[0] += bf_lo(pw.x); v[1] += bf_hi(pw.x); v[2] += bf_lo(pw.y); v[3] += bf_hi(pw.y); v[4] += bf_lo(pw.z); v[5] += bf_hi(pw.z); v[6] += bf_lo(pw.w); v[7] += bf_hi(pw.w); }
                    *(u32x4*)dst = pack8(v);
                }
            }
    }
};
template <class Epi, class Sched, bool ALIGN_EPI = false, bool SP2 = false>
__device__ __forceinline__ void gemm_phase(PG8_LAS unsigned char* lds, const Gemm g, const Sched& S, const Epi& E) {
    const int tid = threadIdx.x, wid = __builtin_amdgcn_readfirstlane(tid >> 6), lane = tid & 63, wr = wid >> 2, wc = wid & 3, fr = lane & 15, fq = lane >> 4;
    const int K = g.K, nt = K / BK;
    unsigned voffA[2], voffB[2];
#pragma unroll
    for (int i = 0; i < 2; ++i) { int R, C; stage_rc(tid * 16 + i * 8192, R, C); const int Rb = Epi::PERM ? ((R & ~31) + perm32(R & 31)) : R;
        voffA[i] = (unsigned)(R * K + C) * 2u; voffB[i] = (unsigned)(Rb * K + C) * 2u; }
    const size_t kstep = (size_t)(BK * 2);
    const size_t hstep = (size_t)HALF * K * 2;
    const size_t tstep = 2 * hstep;
    const unsigned ldsw = (unsigned)wid * 1024u;
    const int aoff = lds_byte(wr * 64 + fr, fq * 8), boff = lds_byte(wc * 32 + fr, fq * 8);
#define PG8_SA(b, h) (((b) * 2 + (h)) * HTB)
#define PG8_SB(b, h) ((4 + (b) * 2 + (h)) * HTB)
#define PG8_STAGE(bufoff, gbase, voff) do { _Pragma("unroll") for (int _i = 0; _i < 2; ++_i) \
        __builtin_amdgcn_global_load_lds((const unsigned*)((const char*)(gbase) + (voff)[_i]), (PG8_LAS unsigned*)(lds + (bufoff) + ldsw + _i * 8192), 16, 0, 0); } while (0)
#define PG8_LDA(dst, b, h) do { _Pragma("unroll") for (int m = 0; m < 4; ++m) _Pragma("unroll") for (int k = 0; k < 2; ++k) dst[m][k] = *(const PG8_LAS bf16x8*)(lds + PG8_SA(b, h) + aoff + m * 2048 + k * 1024); } while (0)
#define PG8_LDB(dst, b, h) do { _Pragma("unroll") for (int n = 0; n < 2; ++n) _Pragma("unroll") for (int k = 0; k < 2; ++k) dst[n][k] = *(const PG8_LAS bf16x8*)(lds + PG8_SB(b, h) + boff + n * 2048 + k * 1024); } while (0)
#define PG8_MMA(ai, bj, At, Bt) do { __builtin_amdgcn_s_setprio(1); _Pragma("unroll") for (int m = 0; m < 4; ++m) _Pragma("unroll") for (int n = 0; n < 2; ++n) _Pragma("unroll") for (int k = 0; k < 2; ++k) \
        acc[ai][bj][m][n] = __builtin_amdgcn_mfma_f32_16x16x32_bf16(Bt[n][k], At[m][k], acc[ai][bj][m][n], 0, 0, 0); __builtin_amdgcn_s_setprio(0); } while (0)
#define PG8_WAIT_V(n) asm volatile("s_waitcnt vmcnt(" #n ")" ::: "memory")
#define PG8_WAIT_L(n) asm volatile("s_waitcnt lgkmcnt(" #n ")" ::: "memory")
#define PG8_BAR __builtin_amdgcn_s_barrier()
#define PG8_SCHED __builtin_amdgcn_sched_barrier(0)
    Unit cur, nxt; int ui = 0;
    if (!S.next(0, cur)) return;
    f32x4 acc[2][2][4][2];
#pragma unroll
    for (int a = 0; a < 2; ++a)
#pragma unroll
        for (int b = 0; b < 2; ++b)
#pragma unroll
            for (int m = 0; m < 4; ++m)
#pragma unroll
                for (int n = 0; n < 2; ++n) acc[a][b][m][n] = (f32x4){0.f, 0.f, 0.f, 0.f};
    bf16x8 At[4][2], B0[2][2], B1[2][2];
    const char* cA = (const char*)g.A + (size_t)cur.pm * tstep; const char* cB = (const char*)g.Bt + (size_t)cur.pn * tstep;
    S.a_ready(cur);
    if constexpr (SP2) {
        PG8_STAGE(PG8_SB(0, 0), cB, voffB); PG8_STAGE(PG8_SB(0, 1), cB + hstep, voffB); PG8_STAGE(PG8_SA(0, 0), cA, voffA); PG8_STAGE(PG8_SA(0, 1), cA + hstep, voffA);
        if (wr == 1) PG8_BAR;
        PG8_WAIT_V(2); PG8_BAR;
        PG8_STAGE(PG8_SB(1, 0), cB + kstep, voffB); PG8_STAGE(PG8_SA(1, 0), cA + kstep, voffA); PG8_STAGE(PG8_SB(1, 1), cB + hstep + kstep, voffB);
        PG8_WAIT_V(6); PG8_BAR;
    } else {
        PG8_STAGE(PG8_SB(0, 0), cB, voffB); PG8_STAGE(PG8_SA(0, 0), cA, voffA); PG8_STAGE(PG8_SB(0, 1), cB + hstep, voffB); PG8_STAGE(PG8_SA(0, 1), cA + hstep, voffA);
        if (wr == 1) PG8_BAR;
        PG8_WAIT_V(4); PG8_BAR;
        PG8_STAGE(PG8_SB(1, 0), cB + kstep, voffB); PG8_STAGE(PG8_SA(1, 0), cA + kstep, voffA); PG8_STAGE(PG8_SB(1, 1), cB + hstep + kstep, voffB);
        PG8_WAIT_V(6); PG8_BAR;
    }
    for (;;) {
        const bool has_next = S.next(ui + 1, nxt);
        const char* nA = has_next ? (const char*)g.A + (size_t)nxt.pm * tstep : cA; const char* nB = has_next ? (const char*)g.Bt + (size_t)nxt.pn * tstep : cB;
        for (int t = 0; t < nt; t += 2) {
            const bool last = (t == nt - 2);
            const char* a1 = cA + (size_t)(t + 1) * kstep;
            const char* a2 = last ? nA : cA + (size_t)(t + 2) * kstep; const char* b2 = last ? nB : cB + (size_t)(t + 2) * kstep;
            const char* a3 = a2 + kstep; const char* b3 = b2 + kstep;
            if (last && has_next) S.a_ready(nxt);
            if constexpr (SP2) {
            PG8_LDB(B0, 0, 0); PG8_LDB(B1, 0, 1); PG8_SCHED; PG8_LDA(At, 0, 0); PG8_STAGE(PG8_SA(1, 1), a1 + hstep, voffA);
            PG8_WAIT_V(8); PG8_WAIT_L(0); PG8_BAR; PG8_MMA(0, 0, At, B0); PG8_MMA(0, 1, At, B1); PG8_BAR; PG8_SCHED;
            PG8_LDA(At, 0, 1); PG8_STAGE(PG8_SB(0, 0), b2, voffB); PG8_STAGE(PG8_SB(0, 1), b2 + hstep, voffB); PG8_STAGE(PG8_SA(0, 0), a2, voffA);
            PG8_WAIT_V(8); PG8_WAIT_L(0); PG8_BAR; PG8_MMA(1, 0, At, B0); PG8_MMA(1, 1, At, B1); PG8_BAR; PG8_SCHED;
            PG8_LDB(B0, 1, 0); PG8_LDB(B1, 1, 1); PG8_SCHED; PG8_LDA(At, 1, 0); PG8_STAGE(PG8_SA(0, 1), a2 + hstep, voffA);
            PG8_WAIT_V(8); PG8_WAIT_L(0); PG8_BAR; PG8_MMA(0, 0, At, B0); PG8_MMA(0, 1, At, B1); PG8_BAR; PG8_SCHED;
            PG8_LDA(At, 1, 1); PG8_STAGE(PG8_SB(1, 0), b3, voffB); PG8_STAGE(PG8_SB(1, 1), b3 + hstep, voffB); PG8_STAGE(PG8_SA(1, 0), a3, voffA);
            PG8_WAIT_V(8); PG8_WAIT_L(0); PG8_BAR; PG8_MMA(1, 0, At, B0); PG8_MMA(1, 1, At, B1); PG8_BAR; PG8_SCHED;
            } else {
            PG8_LDB(B0, 0, 0); PG8_SCHED; PG8_LDA(At, 0, 0); PG8_STAGE(PG8_SA(1, 1), a1 + hstep, voffA);
            PG8_WAIT_L(8); PG8_BAR; PG8_WAIT_L(0); PG8_MMA(0, 0, At, B0); PG8_BAR; PG8_SCHED;
            PG8_LDB(B1, 0, 1); PG8_STAGE(PG8_SB(0, 0), b2, voffB);
            PG8_BAR; PG8_WAIT_L(0); PG8_MMA(0, 1, At, B1); PG8_BAR;
            PG8_LDA(At, 0, 1); PG8_STAGE(PG8_SA(0, 0), a2, voffA);
            PG8_BAR; PG8_WAIT_L(0); PG8_MMA(1, 0, At, B0); PG8_BAR; PG8_SCHED;
            PG8_STAGE(PG8_SB(0, 1), b2 + hstep, voffB);
            PG8_WAIT_V(6); PG8_BAR; PG8_MMA(1, 1, At, B1); PG8_BAR;
            PG8_LDB(B0, 1, 0); PG8_SCHED; PG8_LDA(At, 1, 0); PG8_STAGE(PG8_SA(0, 1), a2 + hstep, voffA);
            PG8_WAIT_L(8); PG8_BAR; PG8_WAIT_L(0); PG8_MMA(0, 0, At, B0); PG8_BAR; PG8_SCHED;
            PG8_LDB(B1, 1, 1); PG8_STAGE(PG8_SB(1, 0), b3, voffB);
            PG8_BAR; PG8_WAIT_L(0); PG8_MMA(0, 1, At, B1); PG8_BAR;
            PG8_LDA(At, 1, 1); PG8_STAGE(PG8_SA(1, 0), a3, voffA);
            PG8_BAR; PG8_WAIT_L(0); PG8_MMA(1, 0, At, B0); PG8_BAR; PG8_SCHED;
            PG8_STAGE(PG8_SB(1, 1), b3 + hstep, voffB);
            PG8_WAIT_V(6); PG8_BAR; PG8_MMA(1, 1, At, B1); PG8_BAR;
            }
        }
        if constexpr (ALIGN_EPI) { if (wr == 0) PG8_BAR; }
        if constexpr (!Epi::AFTER_DRAIN) { E(acc, cur, wr, wc, fr, fq); S.done(cur); }
        if (!has_next) break;
#pragma unroll
        for (int a = 0; a < 2; ++a)
#pragma unroll
            for (int b = 0; b < 2; ++b)
#pragma unroll
                for (int m = 0; m < 4; ++m)
#pragma unroll
                    for (int n = 0; n < 2; ++n) acc[a][b][m][n] = (f32x4){0.f, 0.f, 0.f, 0.f};
        cur = nxt; cA = nA; cB = nB; ++ui;
        if constexpr (ALIGN_EPI) { if (wr == 1) PG8_BAR; }
    }
    PG8_WAIT_V(0);
    if constexpr (!ALIGN_EPI) { if (wr == 0) PG8_BAR; }
    PG8_BAR;
    if constexpr (Epi::AFTER_DRAIN) { E.fused(acc, cur, wr, wc, fr, fq, lds, wid, lane); S.done(cur); }
#undef PG8_SA
#undef PG8_SB
#undef PG8_STAGE
#undef PG8_LDA
#undef PG8_LDB
#undef PG8_MMA
#undef PG8_WAIT_V
#undef PG8_WAIT_L
#undef PG8_BAR
#undef PG8_SCHED
}
}

constexpr int BATCH = 2, SEQ = 8192, DM = 1024, DFF = 2816, T = BATCH * SEQ;
constexpr int NIN = 4352;
constexpr float EPS = 1e-6f;
constexpr float LOG2E = 1.4426950408889634f;
constexpr float QS_MLA = 0.10206207261596575f * LOG2E;
constexpr float QS_DIL = 0.125f * LOG2E;

typedef unsigned short bf16;
typedef unsigned v4u __attribute__((ext_vector_type(4)));
typedef float f32x4 __attribute__((ext_vector_type(4)));
#define LAS __attribute__((address_space(3)))
#define LDS_WAIT() asm volatile("s_waitcnt lgkmcnt(0)" ::: "memory")

constexpr size_t MiB = 1u << 20;
constexpr size_t WS_CTL = 0;
constexpr size_t WS_WGU1 = 1 * MiB;
constexpr size_t WS_WD1 = WS_WGU1 + 11 * MiB;
constexpr size_t WS_WGU2 = WS_WD1 + 11 * MiB / 2;
constexpr size_t WS_WD2 = WS_WGU2 + 11 * MiB;
constexpr size_t WS_WIN = WS_WD2 + 11 * MiB / 2;
constexpr size_t WS_WUQ = WS_WIN + 17 * MiB / 2;
constexpr size_t WS_WUKV = WS_WUQ + 589824;
constexpr size_t WS_WA = WS_WUKV + 524288;
constexpr size_t WS_WB = WS_WA + 1 * MiB;
constexpr size_t WS_WO = WS_WB + 1 * MiB;
constexpr size_t WS_ROPEA = WS_WO + 2 * MiB;
constexpr size_t WS_ROPEB = WS_ROPEA + 2 * MiB;
constexpr size_t WS_SSQ = WS_ROPEB + 1 * MiB;
constexpr size_t WS_XN = 53 * MiB;
static_assert(WS_SSQ + (size_t)T * 20 * 4 <= WS_XN, "ws map");
constexpr size_t WS_R = 85 * MiB;
constexpr size_t WS_HMID = WS_R;
constexpr size_t WS_F = WS_R + 88 * MiB;
constexpr size_t WS_CQ = WS_R, WS_CKV = WS_R + 12 * MiB, WS_KR = WS_R + 20 * MiB, WS_DQ = WS_R + 24 * MiB, WS_DK = WS_R + 40 * MiB, WS_DV = WS_R + 56 * MiB,
                 WS_GT = WS_R + 72 * MiB, WS_KN = WS_R + 136 * MiB, WS_VA = WS_R + 152 * MiB, WS_END = WS_R + 168 * MiB;
constexpr size_t WS_Q = WS_XN;
constexpr size_t WS_OA = WS_CQ;
constexpr size_t WS_OB = WS_DQ;
constexpr size_t WS_MG = WS_KN;
constexpr size_t WS_F2 = WS_R;
static_assert(WS_END <= 256 * MiB, "ws map fits 256 MiB");

__device__ __forceinline__ unsigned f2bf(float f) { unsigned u = __builtin_bit_cast(unsigned, f); return (u + 0x7fffu + ((u >> 16) & 1u)) >> 16; }
__device__ __forceinline__ unsigned pk2(float lo, float hi) { return f2bf(lo) | (f2bf(hi) << 16); }
__device__ __forceinline__ float bf2f(unsigned short b) { return __uint_as_float((unsigned)b << 16); }
__device__ __forceinline__ float wave_sum(float v) {
#pragma unroll
    for (int o = 1; o < 64; o <<= 1) v += __shfl_xor(v, o);
    return v;
}

__device__ __forceinline__ void transpose_item(const float* W, int K, int N, bf16* WT, int k0, int n0, int drow0, const float* kscale, LAS float* scr, int lane) {
#pragma unroll 8
    for (int i = 0; i < 32; ++i) { const int kk = 2 * i + (lane >> 5); float w = W[(size_t)(k0 + kk) * N + n0 + (lane & 31)]; if (kscale) w *= kscale[k0 + kk]; scr[kk * 33 + (lane & 31)] = w; }
    LDS_WAIT(); asm volatile("" ::: "memory");
    const int c = lane & 7;
#pragma unroll
    for (int j = 0; j < 4; ++j) { const int n = (lane >> 3) + 8 * j; const LAS float* s = scr + (8 * c) * 33 + n;
        v4u o; o.x = pk2(s[0 * 33], s[1 * 33]); o.y = pk2(s[2 * 33], s[3 * 33]); o.z = pk2(s[4 * 33], s[5 * 33]); o.w = pk2(s[6 * 33], s[7 * 33]);
        *(v4u*)(WT + (size_t)(drow0 + n) * K + k0 + 8 * c) = o; }
    LDS_WAIT(); asm volatile("" ::: "memory");
}
struct ProArgs {
    const float* x; const int* pos; const float* g_pre1;
    const float *wg1, *wu1, *wd1, *wg2, *wu2, *wd2, *win, *wuq, *wuk, *wuv, *wa, *wb, *wo, *gq, *gkv;
    unsigned char* ws; float invA[16]; float invB[8];
};
__device__ __forceinline__ void rms_row_to_bf16(const float* xrow, const float* g, bf16* orow, int lane) {
    const f32x4* xr = (const f32x4*)xrow + lane; const f32x4* gr = (const f32x4*)g + lane;
    f32x4 v[4]; float s = 0.f;
#pragma unroll
    for (int j = 0; j < 4; ++j) { v[j] = xr[64 * j]; s += (v[j].x * v[j].x + v[j].y * v[j].y) + (v[j].z * v[j].z + v[j].w * v[j].w); }
    const float rstd = 1.0f / sqrtf(wave_sum(s) * (1.f / DM) + EPS);
    unsigned long long* o8 = (unsigned long long*)orow + lane;
#pragma unroll
    for (int j = 0; j < 4; ++j) { const f32x4 gg = gr[64 * j]; o8[64 * j] = (unsigned long long)pk2(v[j].x * rstd * gg.x, v[j].y * rstd * gg.y) | ((unsigned long long)pk2(v[j].z * rstd * gg.z, v[j].w * rstd * gg.w) << 32); }
}
__device__ __forceinline__ void sincos_acc(float angf, float& sn, float& cs) {
    const double a = (double)angf; const double k = rint(a * 0.63661977236758134308);
    const double r = fma(-k, 6.123233995736766e-17, fma(-k, 1.5707963267948966, a)); const double r2 = r * r;
    const double s = r * (1.0 + r2 * (-1.0 / 6 + r2 * (1.0 / 120 + r2 * (-1.0 / 5040 + r2 * (1.0 / 362880 + r2 * (-1.0 / 39916800))))));
    const double c = 1.0 + r2 * (-0.5 + r2 * (1.0 / 24 + r2 * (-1.0 / 720 + r2 * (1.0 / 40320 + r2 * (-1.0 / 3628800 + r2 * (1.0 / 479001600))))));
    const int q = ((int)k) & 3;
    const double ss = (q == 0) ? s : (q == 1) ? c : (q == 2) ? -s : -c; const double cc = (q == 0) ? c : (q == 1) ? -s : (q == 2) ? -c : s;
    sn = (float)ss; cs = (float)cc;
}
__device__ __forceinline__ void prologue_body(const ProArgs& a, LAS unsigned char* lds, int vcu, int G) {
    const int tid = threadIdx.x, lane = tid & 63, wave = __builtin_amdgcn_readfirstlane(tid >> 6);
    LAS float* scr = (LAS float*)(lds + wave * 16384);
    const int gw = vcu * 8 + wave, NGW = G * 8;
    unsigned char* ws = a.ws;
    constexpr int I_GU = 16 * 88, I_D = 44 * 32, I_IN = 16 * 133, I_UQ = 6 * 24, I_UK = 4 * 16, I_AB = 8 * 32, I_O = 16 * 32;
    constexpr int NITEMS = 6 * I_GU + I_IN + I_UQ + 2 * I_UK + 2 * I_AB + I_O;
    static_assert(I_D == I_GU, "item counts");
    for (int it = gw; it < NITEMS; it += NGW) {
        int r = it;
        if (r < 4 * I_GU) {
            const int which = r / I_GU; r -= which * I_GU; const int kb = r / 88, nb = r % 88, n0 = nb * 32;
            const float* W = which == 0 ? a.wg1 : which == 1 ? a.wu1 : which == 2 ? a.wg2 : a.wu2;
            bf16* WT = (bf16*)(ws + (which < 2 ? WS_WGU1 : WS_WGU2));
            transpose_item(W, DM, DFF, WT, kb * 64, n0, 256 * (n0 >> 7) + 128 * (which & 1) + (n0 & 127), nullptr, scr, lane); continue; }
        r -= 4 * I_GU;
        if (r < 2 * I_D) { const int which = r / I_D; r -= which * I_D; const int kb = r / 32, nb = r % 32;
            transpose_item(which ? a.wd2 : a.wd1, DFF, DM, (bf16*)(ws + (which ? WS_WD2 : WS_WD1)), kb * 64, nb * 32, nb * 32, nullptr, scr, lane); continue; }
        r -= 2 * I_D;
        if (r < I_IN) { const int kb = r / 133, nb = r % 133, n0 = nb * 32;
            transpose_item(a.win, DM, 4256, (bf16*)(ws + WS_WIN), kb * 64, n0, n0 < 672 ? n0 : n0 + 96, nullptr, scr, lane); continue; }
        r -= I_IN;
        if (r < I_UQ) { const int kb = r / 24, nb = r % 24; transpose_item(a.wuq, 384, 768, (bf16*)(ws + WS_WUQ), kb * 64, nb * 32, nb * 32, a.gq, scr, lane); continue; }
        r -= I_UQ;
        if (r < 2 * I_UK) { const int which = r / I_UK; r -= which * I_UK; const int kb = r / 16, nb = r % 16;
            transpose_item(which ? a.wuv : a.wuk, 256, 512, (bf16*)(ws + WS_WUKV), kb * 64, nb * 32, which * 512 + nb * 32, a.gkv, scr, lane); continue; }
        r -= 2 * I_UK;
        if (r < 2 * I_AB) { const int which = r / I_AB; r -= which * I_AB; const int kb = r / 32, nb = r % 32;
            transpose_item(which ? a.wb : a.wa, 512, DM, (bf16*)(ws + (which ? WS_WB : WS_WA)), kb * 64, nb * 32, nb * 32, nullptr, scr, lane); continue; }
        r -= 2 * I_AB;
        { const int kb = r / 32, nb = r % 32; transpose_item(a.wo, DM, DM, (bf16*)(ws + WS_WO), kb * 64, nb * 32, nb * 32, nullptr, scr, lane); }
    }
    { const int gt = vcu * 512 + tid; if (gt < 12288) ((v4u*)(ws + WS_WIN + (size_t)672 * 2048))[gt] = (v4u){0u, 0u, 0u, 0u}; }
    for (int m = gw; m < T; m += NGW) rms_row_to_bf16(a.x + (size_t)m * DM, a.g_pre1, (bf16*)(ws + WS_XN) + (size_t)m * DM, lane);
    for (int i = vcu * 512 + tid; i < T * 24; i += G * 512) {
        const int row = i / 24, f = i % 24; const float p = (float)a.pos[row];
        float sn, cs;
        if (f < 16) { sincos_acc(p * a.invA[f], sn, cs); float* o = (float*)(ws + WS_ROPEA) + (size_t)row * 32; o[f] = cs; o[16 + f] = sn; }
        else { sincos_acc(p * a.invB[f - 16], sn, cs); float* o = (float*)(ws + WS_ROPEB) + (size_t)row * 16; o[f - 16] = cs; o[8 + f - 16] = sn; }
    }
}
__global__ void __launch_bounds__(512, 2) prologue_k(ProArgs a) {
    extern __shared__ __attribute__((aligned(16))) unsigned char lds[];
    const int G = gridDim.x, bx = blockIdx.x; const int vcu = (G % 8 == 0) ? (bx % 8) * (G / 8) + bx / 8 : bx;
    prologue_body(a, (LAS unsigned char*)lds, vcu, G);
}

template <class Epi, bool ALIGN>
__global__ void __launch_bounds__(512, 2) gemm_k(pg8::Gemm g, Epi E) {
    extern __shared__ __attribute__((aligned(16))) unsigned char lds[];
    pg8::StaticOrder S; S.init(g.M, g.N, gridDim.x, (int)blockIdx.x);
    pg8::gemm_phase<Epi, pg8::StaticOrder, ALIGN, true>((PG8_LAS unsigned char*)lds, g, S, E);
}

template <bool XN>
__global__ void __launch_bounds__(512) norm_res_k(const float* base, const float* F, const float* g1, float coef, float* out, const float* g2, bf16* xn) {
    const int lane = threadIdx.x & 63, gw = blockIdx.x * 8 + (threadIdx.x >> 6), NGW = gridDim.x * 8;
    for (int m = gw; m < T; m += NGW) {
        const f32x4* fr = (const f32x4*)(F + (size_t)m * DM) + lane; const f32x4* br = (const f32x4*)(base + (size_t)m * DM) + lane;
        f32x4 f[4], h[4]; float s = 0.f;
#pragma unroll
        for (int j = 0; j < 4; ++j) { f[j] = fr[64 * j]; h[j] = br[64 * j]; s += (f[j].x * f[j].x + f[j].y * f[j].y) + (f[j].z * f[j].z + f[j].w * f[j].w); }
        const float rs = coef / sqrtf(wave_sum(s) * (1.f / DM) + EPS); float s2 = 0.f;
#pragma unroll
        for (int j = 0; j < 4; ++j) { const f32x4 gg = ((const f32x4*)g1 + lane)[64 * j]; h[j] = h[j] + f[j] * rs * gg; s2 += (h[j].x * h[j].x + h[j].y * h[j].y) + (h[j].z * h[j].z + h[j].w * h[j].w); }
        f32x4* orow = (f32x4*)(out + (size_t)m * DM) + lane;
#pragma unroll
        for (int j = 0; j < 4; ++j) orow[64 * j] = h[j];
        if (XN) {
            const float r2 = 1.0f / sqrtf(wave_sum(s2) * (1.f / DM) + EPS);
            unsigned long long* o8 = (unsigned long long*)(xn + (size_t)m * DM) + lane;
#pragma unroll
            for (int j = 0; j < 4; ++j) { const f32x4 gg = ((const f32x4*)g2 + lane)[64 * j];
                o8[64 * j] = (unsigned long long)pk2(h[j].x * r2 * gg.x, h[j].y * r2 * gg.y) | ((unsigned long long)pk2(h[j].z * r2 * gg.z, h[j].w * r2 * gg.w) << 32); }
        }
    }
}

__global__ void __launch_bounds__(256) mla_naive_k(const bf16* Q, const bf16* KN, const bf16* KR, const bf16* VA, bf16* OA) {
    __shared__ float Ks[32][96]; __shared__ float Vs[32][64];
    const int bh = blockIdx.x >> 5, qb = blockIdx.x & 31, b = bh >> 3, h = bh & 7, tid = threadIdx.x;
    const size_t t = (size_t)b * SEQ + qb * 256 + tid;
    float q[96], o[64];
#pragma unroll
    for (int c = 0; c < 12; ++c) { const v4u w = *(const v4u*)(Q + t * 768 + h * 96 + c * 8);
        q[c * 8 + 0] = pg8::bf_lo(w.x); q[c * 8 + 1] = pg8::bf_hi(w.x); q[c * 8 + 2] = pg8::bf_lo(w.y); q[c * 8 + 3] = pg8::bf_hi(w.y);
        q[c * 8 + 4] = pg8::bf_lo(w.z); q[c * 8 + 5] = pg8::bf_hi(w.z); q[c * 8 + 6] = pg8::bf_lo(w.w); q[c * 8 + 7] = pg8::bf_hi(w.w); }
#pragma unroll
    for (int d = 0; d < 64; ++d) o[d] = 0.f;
    float m = -1e30f, l = 0.f;
    const int key = tid >> 3, part = tid & 7;
    for (int kt = 0; kt < SEQ / 32; ++kt) {
        __syncthreads();
        { const size_t kr = (size_t)b * SEQ + kt * 32 + key;
            const v4u w = *(const v4u*)(KN + kr * 512 + h * 64 + part * 8);
            float* d = &Ks[key][part * 8];
            d[0] = pg8::bf_lo(w.x); d[1] = pg8::bf_hi(w.x); d[2] = pg8::bf_lo(w.y); d[3] = pg8::bf_hi(w.y); d[4] = pg8::bf_lo(w.z); d[5] = pg8::bf_hi(w.z); d[6] = pg8::bf_lo(w.w); d[7] = pg8::bf_hi(w.w);
            const v4u v = *(const v4u*)(VA + kr * 512 + h * 64 + part * 8);
            float* e = &Vs[key][part * 8];
            e[0] = pg8::bf_lo(v.x); e[1] = pg8::bf_hi(v.x); e[2] = pg8::bf_lo(v.y); e[3] = pg8::bf_hi(v.y); e[4] = pg8::bf_lo(v.z); e[5] = pg8::bf_hi(v.z); e[6] = pg8::bf_lo(v.w); e[7] = pg8::bf_hi(v.w);
            if (part < 4) { const v4u r = *(const v4u*)(KR + kr * 32 + part * 8); float* g = &Ks[key][64 + part * 8];
                g[0] = pg8::bf_lo(r.x); g[1] = pg8::bf_hi(r.x); g[2] = pg8::bf_lo(r.y); g[3] = pg8::bf_hi(r.y); g[4] = pg8::bf_lo(r.z); g[5] = pg8::bf_hi(r.z); g[6] = pg8::bf_lo(r.w); g[7] = pg8::bf_hi(r.w); } }
        __syncthreads();
        for (int k = 0; k < 32; ++k) {
            float s = 0.f;
#pragma unroll
            for (int d = 0; d < 96; ++d) s += q[d] * Ks[k][d];
            const float mn = fmaxf(m, s), al = __builtin_amdgcn_exp2f(m - mn), p = __builtin_amdgcn_exp2f(s - mn);
            l = l * al + p; m = mn;
#pragma unroll
            for (int d = 0; d < 64; ++d) o[d] = o[d] * al + p * Vs[k][d];
        }
    }
    const float il = 1.0f / l;
#pragma unroll
    for (int c = 0; c < 8; ++c) { v4u w; w.x = pk2(o[c * 8 + 0] * il, o[c * 8 + 1] * il); w.y = pk2(o[c * 8 + 2] * il, o[c * 8 + 3] * il); w.z = pk2(o[c * 8 + 4] * il, o[c * 8 + 5] * il); w.w = pk2(o[c * 8 + 6] * il, o[c * 8 + 7] * il);
        *(v4u*)(OA + t * 512 + h * 64 + c * 8) = w; }
}
__global__ void __launch_bounds__(256) dil_naive_k(const bf16* DQ, const bf16* DK, const bf16* DV, bf16* OB) {
    const int idx = blockIdx.x * 256 + threadIdx.x; const int s = idx & (SEQ - 1), bh = idx >> 13, b = bh >> 3, h = bh & 7;
    const size_t t = (size_t)b * SEQ + s;
    float q[64], o[64];
#pragma unroll
    for (int c = 0; c < 8; ++c) { const v4u w = *(const v4u*)(DQ + t * 512 + h * 64 + c * 8);
        q[c * 8 + 0] = pg8::bf_lo(w.x); q[c * 8 + 1] = pg8::bf_hi(w.x); q[c * 8 + 2] = pg8::bf_lo(w.y); q[c * 8 + 3] = pg8::bf_hi(w.y);
        q[c * 8 + 4] = pg8::bf_lo(w.z); q[c * 8 + 5] = pg8::bf_hi(w.z); q[c * 8 + 6] = pg8::bf_lo(w.w); q[c * 8 + 7] = pg8::bf_hi(w.w); }
#pragma unroll
    for (int d = 0; d < 64; ++d) o[d] = 0.f;
    float m = -1e30f, l = 0.f;
    for (int pat = 0; pat < 3; ++pat) {
        const int dil = pat == 0 ? 1 : pat == 1 ? 4 : 16;
        for (int j = -64; j <= 64; ++j) {
            const int sk = s + j * dil; if (sk < 0 || sk >= SEQ) continue;
            const size_t kr = ((size_t)b * SEQ + sk) * 512 + h * 64;
            float sc = 0.f;
#pragma unroll
            for (int c = 0; c < 8; ++c) { const v4u w = *(const v4u*)(DK + kr + c * 8);
                sc += q[c * 8 + 0] * pg8::bf_lo(w.x) + q[c * 8 + 1] * pg8::bf_hi(w.x) + q[c * 8 + 2] * pg8::bf_lo(w.y) + q[c * 8 + 3] * pg8::bf_hi(w.y)
                    + q[c * 8 + 4] * pg8::bf_lo(w.z) + q[c * 8 + 5] * pg8::bf_hi(w.z) + q[c * 8 + 6] * pg8::bf_lo(w.w) + q[c * 8 + 7] * pg8::bf_hi(w.w); }
            const float mn = fmaxf(m, sc), al = __builtin_amdgcn_exp2f(m - mn), p = __builtin_amdgcn_exp2f(sc - mn);
            l = l * al + p; m = mn;
#pragma unroll
            for (int c = 0; c < 8; ++c) { const v4u w = *(const v4u*)(DV + kr + c * 8);
                o[c * 8 + 0] = o[c * 8 + 0] * al + p * pg8::bf_lo(w.x); o[c * 8 + 1] = o[c * 8 + 1] * al + p * pg8::bf_hi(w.x);
                o[c * 8 + 2] = o[c * 8 + 2] * al + p * pg8::bf_lo(w.y); o[c * 8 + 3] = o[c * 8 + 3] * al + p * pg8::bf_hi(w.y);
                o[c * 8 + 4] = o[c * 8 + 4] * al + p * pg8::bf_lo(w.z); o[c * 8 + 5] = o[c * 8 + 5] * al + p * pg8::bf_hi(w.z);
                o[c * 8 + 6] = o[c * 8 + 6] * al + p * pg8::bf_lo(w.w); o[c * 8 + 7] = o[c * 8 + 7] * al + p * pg8::bf_hi(w.w); }
        }
    }
    const float il = 1.0f / l;
#pragma unroll
    for (int c = 0; c < 8; ++c) { v4u w; w.x = pk2(o[c * 8 + 0] * il, o[c * 8 + 1] * il); w.y = pk2(o[c * 8 + 2] * il, o[c * 8 + 3] * il); w.z = pk2(o[c * 8 + 4] * il, o[c * 8 + 5] * il); w.w = pk2(o[c * 8 + 6] * il, o[c * 8 + 7] * il);
        *(v4u*)(OB + t * 512 + h * 64 + c * 8) = w; }
}


namespace mla {
using bf16x8 = __attribute__((ext_vector_type(8))) short;
using s16x4  = __attribute__((ext_vector_type(4))) short;
using f32x16 = __attribute__((ext_vector_type(16))) float;
using u32x4  = __attribute__((ext_vector_type(4))) unsigned;
constexpr int NW = 8, QBLK = 32, KVBLK = 64;
constexpr int SHM_K = 64 * 256, SHM_V = 64 * 64 * 2;
constexpr int LDS_V = 0, LDS_K = 2 * SHM_V, LDS_WS = LDS_K + 2 * SHM_K, LDS_BYTES = LDS_WS + NW * 64 * 4;
constexpr float THRL = 8.0f;
#define MLA_KSWZ(row, colB) ((row) * 256 + ((colB) ^ (((row) & 7) << 4)))
#define MLA_SBAR() __builtin_amdgcn_sched_barrier(0)
__device__ __forceinline__ int crow(int r, int hi) { return (r & 3) + 8 * (r >> 2) + 4 * hi; }
__device__ __forceinline__ unsigned cvtpk(float lo, float hi) { unsigned r; asm volatile("v_cvt_pk_bf16_f32 %0, %1, %2" : "=v"(r) : "v"(lo), "v"(hi)); return r; }

__device__ __forceinline__ void partialSM(f32x16& p0, f32x16& p1, float& m_reg, float& alpha) {
  float pmax = p0[0];
#pragma unroll
  for (int r = 1; r < 16; ++r) pmax = fmaxf(pmax, p0[r]);
#pragma unroll
  for (int r = 0; r < 16; ++r) pmax = fmaxf(pmax, p1[r]);
  { auto rr = __builtin_amdgcn_permlane32_swap(__float_as_uint(pmax), __float_as_uint(pmax), false, false);
    pmax = fmaxf(__uint_as_float(rr[0]), __uint_as_float(rr[1])); }
  float mn;
  if (__builtin_expect(__all(pmax - m_reg <= THRL), 1)) { mn = m_reg; alpha = 1.f; }
  else { mn = fmaxf(m_reg, pmax); alpha = __builtin_amdgcn_exp2f(m_reg - mn); m_reg = mn; }
#pragma unroll
  for (int r = 0; r < 16; ++r) { p0[r] -= mn; p1[r] -= mn; }
#pragma unroll
  for (int r = 0; r < 16; ++r) p0[r] = __builtin_amdgcn_exp2f(p0[r]);
}
__device__ __forceinline__ void finishSM(f32x16& p0, f32x16& p1, float alpha, float& l_reg, bf16x8& pa0, bf16x8& pa1, bf16x8& pa2, bf16x8& pa3) {
#pragma unroll
  for (int r = 0; r < 16; ++r) p1[r] = __builtin_amdgcn_exp2f(p1[r]);
  float ps = 0;
#pragma unroll
  for (int r = 0; r < 16; ++r) ps += p0[r];
#pragma unroll
  for (int r = 0; r < 16; ++r) ps += p1[r];
  { auto rr = __builtin_amdgcn_permlane32_swap(__float_as_uint(ps), __float_as_uint(ps), false, false);
    ps = __uint_as_float(rr[0]) + __uint_as_float(rr[1]); }
  l_reg = l_reg * alpha + ps;
#define MLA_PK4(P, BASE, OUT) do { unsigned a0 = cvtpk(P[BASE + 0], P[BASE + 1]), a1 = cvtpk(P[BASE + 2], P[BASE + 3]);   \
    unsigned b0 = cvtpk(P[BASE + 4], P[BASE + 5]), b1 = cvtpk(P[BASE + 6], P[BASE + 7]);                              \
    auto r0 = __builtin_amdgcn_permlane32_swap(a0, b0, false, false); auto r1 = __builtin_amdgcn_permlane32_swap(a1, b1, false, false); \
    u32x4 w = {r0[0], r1[0], r0[1], r1[1]}; OUT = *reinterpret_cast<bf16x8*>(&w); } while (0)
  MLA_PK4(p0, 0, pa0); MLA_PK4(p0, 8, pa1); MLA_PK4(p1, 0, pa2); MLA_PK4(p1, 8, pa3);
#undef MLA_PK4
}
__device__ __forceinline__ void qkt(f32x16& p0, f32x16& p1, const char* Ks, const bf16x8* qr, int r32, int hi) {
  p0 = f32x16{}; p1 = f32x16{};
#pragma unroll
  for (int d0 = 0; d0 < 6; ++d0) { const int cb = (d0 * 16 + hi * 8) * 2;
    const bf16x8 b0 = *reinterpret_cast<const bf16x8*>(Ks + MLA_KSWZ(r32, cb));
    const bf16x8 b1 = *reinterpret_cast<const bf16x8*>(Ks + MLA_KSWZ(32 + r32, cb));
    p0 = __builtin_amdgcn_mfma_f32_32x32x16_bf16(b0, qr[d0], p0, 0, 0, 0);
    p1 = __builtin_amdgcn_mfma_f32_32x32x16_bf16(b1, qr[d0], p1, 0, 0, 0); }
}
__device__ __forceinline__ int v_st(int k, int c) { const int kk = (k & ~0xC) | ((k & 4) << 1) | ((k & 8) >> 1); return ((kk >> 3) * 2 + (c >> 5)) * 512 + ((kk & 7) * 32 + (c & 31)) * 2; }
__device__ __forceinline__ int v_rd_base(int lane) { return ((lane & 3) << 3) | (((lane >> 2) & 3) << 6) | (((lane >> 4) & 1) << 5) | (((lane >> 5) & 1) << 8); }
constexpr int v_rd_off(int d0, int ks, int half) { return d0 * 512 + ks * 2048 + half * 1024; }
template <int OFF> __device__ __forceinline__ s16x4 tr_read(int vb) {
  s16x4 r; asm volatile("ds_read_b64_tr_b16 %0, %1 offset:%2" : "=&v"(r) : "v"(vb), "i"(OFF) : "memory"); return r;
}
template <int D0> __device__ __forceinline__ void pv_one(f32x16& od, int vb, bf16x8 pa0, bf16x8 pa1, bf16x8 pa2, bf16x8 pa3) {
  const s16x4 l0 = tr_read<v_rd_off(D0, 0, 0)>(vb), h0 = tr_read<v_rd_off(D0, 0, 1)>(vb), l1 = tr_read<v_rd_off(D0, 1, 0)>(vb), h1 = tr_read<v_rd_off(D0, 1, 1)>(vb);
  const s16x4 l2 = tr_read<v_rd_off(D0, 2, 0)>(vb), h2 = tr_read<v_rd_off(D0, 2, 1)>(vb), l3 = tr_read<v_rd_off(D0, 3, 0)>(vb), h3 = tr_read<v_rd_off(D0, 3, 1)>(vb);
  asm volatile("s_waitcnt lgkmcnt(0)" ::: "memory"); MLA_SBAR();
#define MLA_PK(L, H) (bf16x8){L[0], L[1], L[2], L[3], H[0], H[1], H[2], H[3]}
  od = __builtin_amdgcn_mfma_f32_32x32x16_bf16(pa0, MLA_PK(l0, h0), od, 0, 0, 0);
  od = __builtin_amdgcn_mfma_f32_32x32x16_bf16(pa1, MLA_PK(l1, h1), od, 0, 0, 0);
  od = __builtin_amdgcn_mfma_f32_32x32x16_bf16(pa2, MLA_PK(l2, h2), od, 0, 0, 0);
  od = __builtin_amdgcn_mfma_f32_32x32x16_bf16(pa3, MLA_PK(l3, h3), od, 0, 0, 0);
#undef MLA_PK
}
__device__ __forceinline__ void pv_d0(f32x16* o, int vb, bf16x8 pa0, bf16x8 pa1, bf16x8 pa2, bf16x8 pa3) {
  pv_one<0>(o[0], vb, pa0, pa1, pa2, pa3); pv_one<1>(o[1], vb, pa0, pa1, pa2, pa3);
}

__device__ __forceinline__ void attn_unit(int b, int h, int qb, const bf16* __restrict__ Q, const bf16* __restrict__ KN, const bf16* __restrict__ KR, const bf16* __restrict__ VA, bf16* __restrict__ OA, char* lds) {
  const int tid = threadIdx.x, wid = tid >> 6, lane = tid & 63, r32 = lane & 31, hi = lane >> 5;
  char* V_lds = lds + LDS_V; char* K_lds = lds + LDS_K;
  float* ws = (float*)(lds + LDS_WS) + wid * 64; float* li_l = ws; float* al_l = ws + 32;
  const size_t rowbase = (size_t)b * SEQ;
  float m_reg = -1e30f, l_reg = 0; f32x16 o[2] = {}; bf16x8 qr[6];
  const bf16* Qw = Q + (rowbase + qb * 256 + wid * QBLK + r32) * 768 + h * 96 + hi * 8;
#pragma unroll
  for (int d0 = 0; d0 < 6; ++d0) qr[d0] = *reinterpret_cast<const bf16x8*>(Qw + d0 * 16);
  const bf16* KNh = KN + rowbase * 512 + h * 64; const bf16* VAh = VA + rowbase * 512 + h * 64; const bf16* KRb = KR + rowbase * 32;
  const int srow = tid >> 3, sch = tid & 7, rrow = (tid >> 2) & 63, rch = tid & 3;
  const int kst = MLA_KSWZ(srow, sch * 16), rst = MLA_KSWZ(rrow, 128 + rch * 16), vst = v_st(srow, sch * 8);
  const int vb0 = (int)(uintptr_t)V_lds + v_rd_base(lane);
  const bool wr_rope = tid < 256;
  struct { bf16x8 kn, v, kr; } sr_[2];
#define MLA_SLOAD(i, k0) do { sr_[i].v = *reinterpret_cast<const bf16x8*>(&VAh[(size_t)((k0) + srow) * 512 + sch * 8]); \
    sr_[i].kn = *reinterpret_cast<const bf16x8*>(&KNh[(size_t)((k0) + srow) * 512 + sch * 8]); \
    sr_[i].kr = *reinterpret_cast<const bf16x8*>(&KRb[(size_t)((k0) + rrow) * 32 + rch * 8]); } while (0)
#define MLA_SWRITE(bb, i) do { *(bf16x8*)(V_lds + (bb) * SHM_V + vst) = sr_[i].v; *(bf16x8*)(K_lds + (bb) * SHM_K + kst) = sr_[i].kn; \
    if (wr_rope) *(bf16x8*)(K_lds + (bb) * SHM_K + rst) = sr_[i].kr; } while (0)
#define MLA_SWAIT() asm volatile("s_waitcnt vmcnt(3)" ::: "memory")
#define MLA_RESC(a) do { if (__any((a) < 1.f)) { if (hi == 0) al_l[r32] = (a); asm volatile("s_waitcnt lgkmcnt(0)" ::: "memory"); \
    _Pragma("unroll") for (int d = 0; d < 2; ++d) _Pragma("unroll") for (int r = 0; r < 16; ++r) o[d][r] *= al_l[crow(r, hi)]; } } while (0)
  f32x16 pA0, pA1, pB0, pB1; float alA, alB; bf16x8 pa0, pa1, pa2, pa3; constexpr int NT = SEQ / KVBLK;
  MLA_SLOAD(0, 0); asm volatile("s_waitcnt vmcnt(0)" ::: "memory"); MLA_SWRITE(0, 0); __syncthreads();
  qkt(pA0, pA1, K_lds, qr, r32, hi); partialSM(pA0, pA1, m_reg, alA);
  MLA_SLOAD(1, KVBLK); MLA_SLOAD(0, 2 * KVBLK);
  MLA_SWAIT(); MLA_SWRITE(1, 1); __syncthreads();
  for (int j = 1; j + 1 < NT; j += 2) {
    MLA_SBAR(); qkt(pB0, pB1, K_lds + SHM_K, qr, r32, hi);
    finishSM(pA0, pA1, alA, l_reg, pa0, pa1, pa2, pa3); MLA_SBAR();
    MLA_SLOAD(1, (j + 2) * KVBLK); MLA_SBAR();
    pv_d0(o, vb0, pa0, pa1, pa2, pa3); partialSM(pB0, pB1, m_reg, alB);
    __syncthreads(); MLA_SWAIT(); MLA_SWRITE(0, 0);
    MLA_RESC(alB); __syncthreads();
    MLA_SBAR(); qkt(pA0, pA1, K_lds, qr, r32, hi);
    finishSM(pB0, pB1, alB, l_reg, pa0, pa1, pa2, pa3); MLA_SBAR();
    if (j + 3 < NT) MLA_SLOAD(0, (j + 3) * KVBLK); MLA_SBAR();
    pv_d0(o, vb0 + SHM_V, pa0, pa1, pa2, pa3); partialSM(pA0, pA1, m_reg, alA);
    __syncthreads(); MLA_SWAIT(); MLA_SWRITE(1, 1);
    MLA_RESC(alA); __syncthreads();
  }
  MLA_SBAR(); qkt(pB0, pB1, K_lds + SHM_K, qr, r32, hi);
  finishSM(pA0, pA1, alA, l_reg, pa0, pa1, pa2, pa3); MLA_SBAR();
  pv_d0(o, vb0, pa0, pa1, pa2, pa3); partialSM(pB0, pB1, m_reg, alB);
  __syncthreads(); MLA_RESC(alB);
  finishSM(pB0, pB1, alB, l_reg, pa0, pa1, pa2, pa3); MLA_SBAR();
  pv_d0(o, vb0 + SHM_V, pa0, pa1, pa2, pa3);
  if (hi == 0) li_l[r32] = l_reg; asm volatile("s_waitcnt lgkmcnt(0)" ::: "memory");
  float rli[16];
#pragma unroll
  for (int r = 0; r < 16; ++r) rli[r] = __builtin_amdgcn_rcpf(li_l[crow(r, hi)]);
  bf16* Ow = OA + (rowbase + qb * 256 + wid * QBLK) * 512 + h * 64;
#pragma unroll
  for (int r = 0; r < 16; ++r) { const int orow = crow(r, hi);
#pragma unroll
    for (int d0 = 0; d0 < 2; ++d0) Ow[(size_t)orow * 512 + d0 * 32 + r32] = (bf16)f2bf(o[d0][r] * rli[r]); }
#undef MLA_SLOAD
#undef MLA_SWRITE
#undef MLA_SWAIT
#undef MLA_RESC
}
__device__ __forceinline__ void attn_phase(char* lds, const bf16* Q, const bf16* KN, const bf16* KR, const bf16* VA, bf16* OA, int vcu, int G) {
  for (int u = vcu; u < 512; u += G) { const int x = (u & 255) >> 5, j = u & 31, i = u >> 8; const int bh = 2 * x + i;
    attn_unit(bh >> 3, bh & 7, j, Q, KN, KR, VA, OA, lds); }
}
#undef MLA_KSWZ
#undef MLA_SBAR
}
__global__ void __launch_bounds__(512, 2) mla_attn_k(const bf16* Q, const bf16* KN, const bf16* KR, const bf16* VA, bf16* OA) {
    extern __shared__ __attribute__((aligned(16))) unsigned char lds[];
    const int G = gridDim.x, bx = blockIdx.x; const int vcu = (G % 8 == 0) ? (bx % 8) * (G / 8) + bx / 8 : bx;
    mla::attn_phase((char*)lds, Q, KN, KR, VA, OA, vcu, G);
}

namespace dil {
using bf16x8 = __attribute__((ext_vector_type(8))) short;
using s16x4  = __attribute__((ext_vector_type(4))) short;
using f32x16 = __attribute__((ext_vector_type(16))) float;
using u32x4  = __attribute__((ext_vector_type(4))) unsigned;
constexpr int LDS_MO = 0, LDS_ML = 65536, LDS_VS = LDS_ML + 2048, LDS_WS = LDS_VS + 8 * 8192, LDS_BYTES = LDS_WS + 8 * 256;
constexpr float NEG = -1e30f;
#define DIL_SBAR() __builtin_amdgcn_sched_barrier(0)
__device__ __forceinline__ int crow(int r, int hi) { return (r & 3) + 8 * (r >> 2) + 4 * hi; }
__device__ __forceinline__ unsigned cvtpk(float lo, float hi) { unsigned r; asm volatile("v_cvt_pk_bf16_f32 %0, %1, %2" : "=v"(r) : "v"(lo), "v"(hi)); return r; }
__device__ __forceinline__ int v_st(int k, int c) { const int kk = (k & ~0xC) | ((k & 4) << 1) | ((k & 8) >> 1); return ((kk >> 3) * 2 + (c >> 5)) * 512 + ((kk & 7) * 32 + (c & 31)) * 2; }
__device__ __forceinline__ int v_rd_base(int lane) { return ((lane & 3) << 3) | (((lane >> 2) & 3) << 6) | (((lane >> 4) & 1) << 5) | (((lane >> 5) & 1) << 8); }
constexpr int v_rd_off(int d0, int ks, int half) { return d0 * 512 + ks * 2048 + half * 1024; }
template <int OFF> __device__ __forceinline__ s16x4 tr_read(int vb) {
  s16x4 r; asm volatile("ds_read_b64_tr_b16 %0, %1 offset:%2" : "=&v"(r) : "v"(vb), "i"(OFF) : "memory"); return r;
}
template <int D0> __device__ __forceinline__ void pv_one(f32x16& od, int vb, bf16x8 pa0, bf16x8 pa1, bf16x8 pa2, bf16x8 pa3) {
  const s16x4 l0 = tr_read<v_rd_off(D0, 0, 0)>(vb), h0 = tr_read<v_rd_off(D0, 0, 1)>(vb), l1 = tr_read<v_rd_off(D0, 1, 0)>(vb), h1 = tr_read<v_rd_off(D0, 1, 1)>(vb);
  const s16x4 l2 = tr_read<v_rd_off(D0, 2, 0)>(vb), h2 = tr_read<v_rd_off(D0, 2, 1)>(vb), l3 = tr_read<v_rd_off(D0, 3, 0)>(vb), h3 = tr_read<v_rd_off(D0, 3, 1)>(vb);
  asm volatile("s_waitcnt lgkmcnt(0)" ::: "memory"); DIL_SBAR();
#define DIL_PK(L, H) (bf16x8){L[0], L[1], L[2], L[3], H[0], H[1], H[2], H[3]}
  od = __builtin_amdgcn_mfma_f32_32x32x16_bf16(pa0, DIL_PK(l0, h0), od, 0, 0, 0);
  od = __builtin_amdgcn_mfma_f32_32x32x16_bf16(pa1, DIL_PK(l1, h1), od, 0, 0, 0);
  od = __builtin_amdgcn_mfma_f32_32x32x16_bf16(pa2, DIL_PK(l2, h2), od, 0, 0, 0);
  od = __builtin_amdgcn_mfma_f32_32x32x16_bf16(pa3, DIL_PK(l3, h3), od, 0, 0, 0);
#undef DIL_PK
}
#define DIL_PK4(P, BASE, OUT) do { unsigned a0 = cvtpk(P[BASE + 0], P[BASE + 1]), a1 = cvtpk(P[BASE + 2], P[BASE + 3]);   \
    unsigned b0 = cvtpk(P[BASE + 4], P[BASE + 5]), b1 = cvtpk(P[BASE + 6], P[BASE + 7]);                              \
    auto r0 = __builtin_amdgcn_permlane32_swap(a0, b0, false, false); auto r1 = __builtin_amdgcn_permlane32_swap(a1, b1, false, false); \
    u32x4 w = {r0[0], r1[0], r0[1], r1[1]}; OUT = *reinterpret_cast<bf16x8*>(&w); } while (0)

template <int DIL>
__device__ __forceinline__ void score32(f32x16& p, const bf16* DKh, int rcls, int j0, int kk0, const bf16x8* qr, int r32, int hi) {
  constexpr int L = SEQ / DIL;
  const int jk = j0 - 64 + kk0 + r32; const int jc = jk < 0 ? 0 : (jk > L - 1 ? L - 1 : jk);
  const bf16* kp = DKh + ((size_t)jc * DIL + rcls) * 512 + hi * 8;
  bf16x8 kf[4];
#pragma unroll
  for (int d0 = 0; d0 < 4; ++d0) kf[d0] = *reinterpret_cast<const bf16x8*>(kp + d0 * 16);
  p = f32x16{};
#pragma unroll
  for (int d0 = 0; d0 < 4; ++d0) p = __builtin_amdgcn_mfma_f32_32x32x16_bf16(kf[d0], qr[d0], p, 0, 0, 0);
#pragma unroll
  for (int r = 0; r < 16; ++r) { const int kk = kk0 + crow(r, hi); const int j = j0 - 64 + kk;
    const bool ok = (kk >= r32) && (kk <= r32 + 128) && (j >= 0) && (j < L); p[r] = ok ? p[r] : NEG; }
}

template <int DIL, int PASS>
__device__ __forceinline__ void tile(size_t rowbase, int h, int c, int rcls, int j0, const bf16* DQ, const bf16* DK, const bf16* DV, bf16* OB, char* lds, int wid, int lane) {
  constexpr int L = SEQ / DIL;
  const int r32 = lane & 31, hi = lane >> 5;
  const bf16* DKh = DK + rowbase * 512 + h * 64; const bf16* DVh = DV + rowbase * 512 + h * 64;
  bf16x8 qr[4];
  { const int pq = (j0 + r32) * DIL + rcls; const bf16* qp = DQ + (rowbase + pq) * 512 + h * 64 + hi * 8;
#pragma unroll
    for (int d0 = 0; d0 < 4; ++d0) qr[d0] = *reinterpret_cast<const bf16x8*>(qp + d0 * 16); }
  f32x16 s00, s01, s10, s11, s20, s21;
  score32<DIL>(s00, DKh, rcls, j0, 0, qr, r32, hi);   score32<DIL>(s01, DKh, rcls, j0, 32, qr, r32, hi);
  score32<DIL>(s10, DKh, rcls, j0, 64, qr, r32, hi);  score32<DIL>(s11, DKh, rcls, j0, 96, qr, r32, hi);
  score32<DIL>(s20, DKh, rcls, j0, 128, qr, r32, hi); score32<DIL>(s21, DKh, rcls, j0, 160, qr, r32, hi);
  float m = s00[0];
#pragma unroll
  for (int r = 0; r < 16; ++r) { m = fmaxf(m, fmaxf(fmaxf(s00[r], s01[r]), fmaxf(s10[r], s11[r]))); m = fmaxf(m, fmaxf(s20[r], s21[r])); }
  { auto rr = __builtin_amdgcn_permlane32_swap(__float_as_uint(m), __float_as_uint(m), false, false); m = fmaxf(__uint_as_float(rr[0]), __uint_as_float(rr[1])); }
  float l = 0.f;
#pragma unroll
  for (int r = 0; r < 16; ++r) { s00[r] = __builtin_amdgcn_exp2f(s00[r] - m); s01[r] = __builtin_amdgcn_exp2f(s01[r] - m); s10[r] = __builtin_amdgcn_exp2f(s10[r] - m);
    s11[r] = __builtin_amdgcn_exp2f(s11[r] - m); s20[r] = __builtin_amdgcn_exp2f(s20[r] - m); s21[r] = __builtin_amdgcn_exp2f(s21[r] - m);
    l += (s00[r] + s01[r]) + (s10[r] + s11[r]) + (s20[r] + s21[r]); }
  { auto rr = __builtin_amdgcn_permlane32_swap(__float_as_uint(l), __float_as_uint(l), false, false); l = __uint_as_float(rr[0]) + __uint_as_float(rr[1]); }
  char* Vw = lds + LDS_VS + wid * 8192; const int vb = (int)(uintptr_t)Vw + v_rd_base(lane);
  f32x16 o[2] = {};
  const int vrow = lane >> 3, vch = (lane & 7) * 8;
#define DIL_STEP(ST, PA, PB) do { bf16x8 vr[8]; \
    _Pragma("unroll") for (int i = 0; i < 8; ++i) { const int jk = j0 - 64 + 64 * (ST) + vrow + 8 * i; const int jc = jk < 0 ? 0 : (jk > L - 1 ? L - 1 : jk); \
      vr[i] = *reinterpret_cast<const bf16x8*>(DVh + ((size_t)jc * DIL + rcls) * 512 + vch); } \
    _Pragma("unroll") for (int i = 0; i < 8; ++i) *(bf16x8*)(Vw + v_st(vrow + 8 * i, vch)) = vr[i]; \
    bf16x8 pa0, pa1, pa2, pa3; DIL_PK4(PA, 0, pa0); DIL_PK4(PA, 8, pa1); DIL_PK4(PB, 0, pa2); DIL_PK4(PB, 8, pa3); \
    asm volatile("s_waitcnt lgkmcnt(0)" ::: "memory"); DIL_SBAR(); \
    pv_one<0>(o[0], vb, pa0, pa1, pa2, pa3); pv_one<1>(o[1], vb, pa0, pa1, pa2, pa3); DIL_SBAR(); } while (0)
  DIL_STEP(0, s00, s01); DIL_STEP(1, s10, s11); DIL_STEP(2, s20, s21);
#undef DIL_STEP
  float* wsf = (float*)(lds + LDS_WS) + wid * 64;
  bf16* MO = (bf16*)(lds + LDS_MO); float* ML = (float*)(lds + LDS_ML);
  const int qpos_l = (j0 + r32) * DIL + rcls - 512 * c;
  if (PASS == 0) {
    if (hi == 0) { wsf[r32] = __builtin_amdgcn_rcpf(l); ML[qpos_l] = m + __builtin_amdgcn_logf(l); }
    asm volatile("s_waitcnt lgkmcnt(0)" ::: "memory");
#pragma unroll
    for (int r = 0; r < 16; ++r) { const int n = crow(r, hi); const float f = wsf[n]; const int qp = (j0 + n) * DIL + rcls - 512 * c;
#pragma unroll
      for (int d0 = 0; d0 < 2; ++d0) MO[qp * 64 + d0 * 32 + r32] = (bf16)f2bf(o[d0][r] * f); }
  } else {
    const float L1 = ML[qpos_l]; const float mx = fmaxf(L1, m);
    const float w1 = __builtin_amdgcn_exp2f(L1 - mx), w2 = __builtin_amdgcn_exp2f(m - mx); const float den = w1 + w2 * l; const float rd = __builtin_amdgcn_rcpf(den);
    if (hi == 0) { wsf[r32] = w1 * rd; wsf[32 + r32] = w2 * rd; }
    asm volatile("s_waitcnt lgkmcnt(0)" ::: "memory");
    if (PASS == 1) { if (hi == 0) ML[qpos_l] = mx + __builtin_amdgcn_logf(den); }
#pragma unroll
    for (int r = 0; r < 16; ++r) { const int n = crow(r, hi); const float f1 = wsf[n], f2 = wsf[32 + n]; const int qp = (j0 + n) * DIL + rcls - 512 * c;
#pragma unroll
      for (int d0 = 0; d0 < 2; ++d0) { const float o1 = bf2f(MO[qp * 64 + d0 * 32 + r32]); const float ov = f1 * o1 + f2 * o[d0][r];
        if (PASS == 1) MO[qp * 64 + d0 * 32 + r32] = (bf16)f2bf(ov);
        else OB[(rowbase + 512 * c + qp) * 512 + h * 64 + d0 * 32 + r32] = (bf16)f2bf(ov); } }
  }
  asm volatile("s_waitcnt lgkmcnt(0)" ::: "memory");
}
__device__ __forceinline__ void unit(int b, int h, int c, const bf16* DQ, const bf16* DK, const bf16* DV, bf16* OB, char* lds) {
  const int tid = threadIdx.x, lane = tid & 63, wid = __builtin_amdgcn_readfirstlane(tid >> 6);
  const size_t rowbase = (size_t)b * SEQ;
#pragma unroll 1
  for (int t = 0; t < 2; ++t) tile<16, 0>(rowbase, h, c, 2 * wid + t, 32 * c, DQ, DK, DV, OB, lds, wid, lane);
  __syncthreads();
#pragma unroll 1
  for (int t = 0; t < 2; ++t) { const int ti = 2 * wid + t; tile<4, 1>(rowbase, h, c, ti >> 2, 128 * c + 32 * (ti & 3), DQ, DK, DV, OB, lds, wid, lane); }
  __syncthreads();
#pragma unroll 1
  for (int t = 0; t < 2; ++t) { const int ti = 2 * wid + t; tile<1, 2>(rowbase, h, c, 0, 512 * c + 32 * ti, DQ, DK, DV, OB, lds, wid, lane); }
  __syncthreads();
}
__device__ __forceinline__ void phase(char* lds, const bf16* DQ, const bf16* DK, const bf16* DV, bf16* OB, int vcu, int G) {
  for (int u = vcu; u < 256; u += G) { const int x = u >> 5, j = u & 31; const int bh = 2 * x + (j >> 4);
    unit(bh >> 3, bh & 7, j & 15, DQ, DK, DV, OB, lds); }
}
#undef DIL_PK4
#undef DIL_SBAR
}
__global__ void __launch_bounds__(512, 2) dil_attn_k(const bf16* DQ, const bf16* DK, const bf16* DV, bf16* OB) {
    extern __shared__ __attribute__((aligned(16))) unsigned char lds[];
    const int G = gridDim.x, bx = blockIdx.x; const int vcu = (G % 8 == 0) ? (bx % 8) * (G / 8) + bx / 8 : bx;
    dil::phase((char*)lds, DQ, DK, DV, OB, vcu, G);
}
template <class Epi, bool ALIGN> static void launch_gemm(const bf16* A, const bf16* Bt, int N, int K, const Epi& E, hipStream_t stream) {
    static bool attr = false;
    if (!attr) { (void)hipFuncSetAttribute((const void*)gemm_k<Epi, ALIGN>, hipFuncAttributeMaxDynamicSharedMemorySize, 131072); attr = true; }
    pg8::Gemm g{A, Bt, T, N, K, 0};
    hipLaunchKernelGGL((gemm_k<Epi, ALIGN>), dim3(256), dim3(512), 131072, stream, g, E);
}
extern "C" void kernel_launch(void* const* d_in, const int* in_sizes, int n_in, void* d_out, int out_size, void* d_ws, size_t ws_size, hipStream_t stream) {
    if (n_in != 24 || in_sizes[0] != T * DM || out_size != T * DM || ws_size < WS_END) { fprintf(stderr, "kernel_launch: unexpected shapes / workspace (%d inputs, ws %zu)\n", n_in, ws_size); return; }
    unsigned char* ws = (unsigned char*)d_ws;
    const float* x = (const float*)d_in[0];
    float* out = (float*)d_out;
    static bool init = false;
    if (!init) { (void)hipFuncSetAttribute((const void*)prologue_k, hipFuncAttributeMaxDynamicSharedMemorySize, 131072); (void)hipFuncSetAttribute((const void*)mla_attn_k, hipFuncAttributeMaxDynamicSharedMemorySize, mla::LDS_BYTES); (void)hipFuncSetAttribute((const void*)dil_attn_k, hipFuncAttributeMaxDynamicSharedMemorySize, dil::LDS_BYTES); init = true; }
    ProArgs pa{};
    pa.x = x; pa.pos = (const int*)d_in[1]; pa.g_pre1 = (const float*)d_in[2];
    pa.wg1 = (const float*)d_in[4]; pa.wu1 = (const float*)d_in[5]; pa.wd1 = (const float*)d_in[6];
    pa.wg2 = (const float*)d_in[21]; pa.wu2 = (const float*)d_in[22]; pa.wd2 = (const float*)d_in[23];
    pa.win = (const float*)d_in[8]; pa.wuq = (const float*)d_in[11]; pa.wuk = (const float*)d_in[13]; pa.wuv = (const float*)d_in[14];
    pa.wa = (const float*)d_in[15]; pa.wb = (const float*)d_in[16]; pa.wo = (const float*)d_in[17]; pa.gq = (const float*)d_in[10]; pa.gkv = (const float*)d_in[12];
    pa.ws = ws;
    for (int i = 0; i < 16; ++i) pa.invA[i] = 1.0f / powf(10000.0f, (float)i / 16.0f);
    for (int i = 0; i < 8; ++i) pa.invB[i] = 1.0f / powf(500000.0f, (float)i / 8.0f);
    hipLaunchKernelGGL(prologue_k, dim3(256), dim3(512), 131072, stream, pa);

    bf16* XN = (bf16*)(ws + WS_XN); bf16* HMID = (bf16*)(ws + WS_HMID); float* F = (float*)(ws + WS_F); float* F2 = (float*)(ws + WS_F2);
    float* ropeA = (float*)(ws + WS_ROPEA); float* ropeB = (float*)(ws + WS_ROPEB); float* SSQ = (float*)(ws + WS_SSQ);
    launch_gemm<pg8::EpiSwiGLU, true>(XN, (const bf16*)(ws + WS_WGU1), 2 * DFF, DM, pg8::EpiSwiGLU{HMID, DFF, 0}, stream);
    launch_gemm<pg8::EpiF32, false>(HMID, (const bf16*)(ws + WS_WD1), DM, DFF, pg8::EpiF32{F, DM, 0}, stream);
    hipLaunchKernelGGL(norm_res_k<true>, dim3(1024), dim3(512), 0, stream, x, (const float*)F, (const float*)d_in[3], 0.5f, out, (const float*)d_in[7], XN);
    { pg8::EpiInProj E{(bf16*)(ws + WS_CQ), (bf16*)(ws + WS_CKV), (bf16*)(ws + WS_KR), (bf16*)(ws + WS_DQ), (bf16*)(ws + WS_DK), (bf16*)(ws + WS_DV), (bf16*)(ws + WS_GT), SSQ,
                       (const float*)d_in[9], ropeA, ropeB, QS_DIL, 0};
      launch_gemm<pg8::EpiInProj, true>(XN, (const bf16*)(ws + WS_WIN), NIN, DM, E, stream); }
    launch_gemm<pg8::EpiQUp, true>((const bf16*)(ws + WS_CQ), (const bf16*)(ws + WS_WUQ), 768, 384, pg8::EpiQUp{(bf16*)(ws + WS_Q), SSQ, ropeA, QS_MLA, EPS}, stream);
    launch_gemm<pg8::EpiKVUp, true>((const bf16*)(ws + WS_CKV), (const bf16*)(ws + WS_WUKV), 1024, 256, pg8::EpiKVUp{(bf16*)(ws + WS_KN), (bf16*)(ws + WS_VA), SSQ, EPS, 0}, stream);
    hipLaunchKernelGGL(dil_attn_k, dim3(256), dim3(512), dil::LDS_BYTES, stream, (const bf16*)(ws + WS_DQ), (const bf16*)(ws + WS_DK), (const bf16*)(ws + WS_DV), (bf16*)(ws + WS_OB));
    hipLaunchKernelGGL(mla_attn_k, dim3(256), dim3(512), mla::LDS_BYTES, stream, (const bf16*)(ws + WS_Q), (const bf16*)(ws + WS_KN), (const bf16*)(ws + WS_KR), (const bf16*)(ws + WS_VA), (bf16*)(ws + WS_OA));
    launch_gemm<pg8::EpiGate<true>, true>((const bf16*)(ws + WS_OA), (const bf16*)(ws + WS_WA), DM, 512, pg8::EpiGate<true>{(bf16*)(ws + WS_MG), (const bf16*)(ws + WS_GT)}, stream);
    launch_gemm<pg8::EpiGate<false>, true>((const bf16*)(ws + WS_OB), (const bf16*)(ws + WS_WB), DM, 512, pg8::EpiGate<false>{(bf16*)(ws + WS_MG), (const bf16*)(ws + WS_GT)}, stream);
    launch_gemm<pg8::EpiF32, false>((const bf16*)(ws + WS_MG), (const bf16*)(ws + WS_WO), DM, DM, pg8::EpiF32{F2, DM, 0}, stream);
    hipLaunchKernelGGL(norm_res_k<true>, dim3(1024), dim3(512), 0, stream, (const float*)out, (const float*)F2, (const float*)d_in[18], 1.0f, out, (const float*)d_in[19], XN);
    launch_gemm<pg8::EpiSwiGLU, true>(XN, (const bf16*)(ws + WS_WGU2), 2 * DFF, DM, pg8::EpiSwiGLU{HMID, DFF, 0}, stream);
    launch_gemm<pg8::EpiF32, false>(HMID, (const bf16*)(ws + WS_WD2), DM, DFF, pg8::EpiF32{F, DM, 0}, stream);
    hipLaunchKernelGGL(norm_res_k<false>, dim3(1024), dim3(512), 0, stream, (const float*)out, (const float*)F, (const float*)d_in[20], 0.5f, out, (const float*)nullptr, (bf16*)nullptr);
}
```
